# Optimizing an MI355X kernel written in HIP

```python
import math
import jax, jax.numpy as jnp
from jax import lax
import numpy as np

D_MODEL = 1024
BATCH = 16
SEQ = 256
DEPTH = 2
DEC_BATCH = 8
DEC_SEQ = 1024
PAST_LEN = 512

GRID_W = 64
EPS = 1e-6
N_A_LAYERS = (DEPTH + 1) // 2
N_C_LAYERS = DEPTH // 2

MLA_HEADS = D_MODEL // 128
Q_RANK = D_MODEL // 4
KV_RANK = D_MODEL // 8
QK_NOPE = 64
QK_ROPE = 32
V_HEAD = 64
MLA_WIDTH = MLA_HEADS * V_HEAD
ATTN_SCALE = (QK_NOPE + QK_ROPE) ** -0.5
ROPE_THETA = 10000.0
Q_BLOCK = 128

CONV_WIDTH = D_MODEL // 2
CONV_K = 31

A_SPLITS = [Q_RANK, Q_RANK + KV_RANK, Q_RANK + KV_RANK + QK_ROPE,
            Q_RANK + KV_RANK + QK_ROPE + 2 * CONV_WIDTH]
A_MIX = MLA_WIDTH + CONV_WIDTH
A_IN = A_SPLITS[-1] + A_MIX

SSD_INNER = 2 * D_MODEL
SSD_HEAD_DIM = 64
SSD_HEADS = SSD_INNER // SSD_HEAD_DIM
SSD_GROUPS = 4
SSD_HPG = SSD_HEADS // SSD_GROUPS
SSD_STATE = 128
SSD_CONV_K = 5
SSD_CHUNK = 128
SSD_CONV_CH = SSD_INNER + 2 * SSD_GROUPS * SSD_STATE
C_IN = SSD_INNER + SSD_CONV_CH + 2 * SSD_HEADS

kernel_name = 'hybrid_mla_conformer_ssd_diffusion_step'


def rmsnorm(x, g):
    xf = x.astype(jnp.float32)
    y = xf * lax.rsqrt(jnp.mean(xf * xf, axis=-1, keepdims=True) + EPS)
    return (y * g.astype(jnp.float32)).astype(x.dtype)


def layernorm(x, g, b):
    xf = x.astype(jnp.float32)
    mu = jnp.mean(xf, axis=-1, keepdims=True)
    xc = xf - mu
    y = xc * lax.rsqrt(jnp.mean(xc * xc, axis=-1, keepdims=True) + EPS)
    return (y * g.astype(jnp.float32) + b.astype(jnp.float32)).astype(x.dtype)


def modulation(cond, w_mod, b_mod):
    m = jax.nn.silu(cond) @ w_mod + b_mod
    shift, scale, gate = jnp.split(m, 3, axis=-1)
    return shift[..., None, :], scale[..., None, :], gate[..., None, :]


def dwconv(x, w, b):
    k = w.shape[0]
    y = lax.conv_general_dilated(x, w[:, None, :].astype(x.dtype), window_strides=(1,),
                                 padding=[(k // 2, k // 2)],
                                 dimension_numbers=('NWC', 'WIO', 'NWC'),
                                 feature_group_count=x.shape[-1])
    return y + b


def axial_rope(length):
    rows = length // GRID_W
    row = jnp.repeat(jnp.arange(rows, dtype=jnp.float32), GRID_W)
    col = jnp.tile(jnp.arange(GRID_W, dtype=jnp.float32), rows)
    n_freq = QK_ROPE // 4
    inv = jnp.power(ROPE_THETA, -jnp.arange(n_freq, dtype=jnp.float32) / n_freq)
    ang = jnp.concatenate([row[:, None] * inv, col[:, None] * inv], axis=-1)
    return jnp.cos(ang), jnp.sin(ang)


def apply_rope(x, cos, sin):
    xf = x.astype(jnp.float32)
    x1, x2 = xf[..., 0::2], xf[..., 1::2]
    out = jnp.stack([x1 * cos - x2 * sin, x1 * sin + x2 * cos], axis=-1).reshape(x.shape)
    return out.astype(x.dtype)


def mla_attend(q_nope, q_rope, k_nope, k_rope, v):
    b, lq, h, _ = q_nope.shape
    nblk = lq // Q_BLOCK

    def to_blocks(t):
        return t.reshape(b, nblk, Q_BLOCK, *t.shape[2:]).swapaxes(0, 1)

    def one_block(qs):
        qn, qr = qs
        s = (jnp.einsum('bqhd,bkhd->bhqk', qn, k_nope, preferred_element_type=jnp.float32)
             + jnp.einsum('bqhr,bkr->bhqk', qr, k_rope, preferred_element_type=jnp.float32)) * ATTN_SCALE
        p = jax.nn.softmax(s, axis=-1).astype(v.dtype)
        return jnp.einsum('bhqk,bkhd->bqhd', p, v)

    out = lax.map(one_block, (to_blocks(q_nope), to_blocks(q_rope)))
    return out.swapaxes(0, 1).reshape(b, lq, h * V_HEAD)


def layer_a(h, w_in, g_q, g_kv, w_uq, w_uk, w_uv, conv_w, conv_b, ln_g, ln_b, w_out,
            ctx_ckv=None, ctx_krope=None):
    b, L, _ = h.shape
    u = h @ w_in
    q_lat, kv_lat, k_rope, glu, gate = jnp.split(u, A_SPLITS, axis=-1)
    ckv = rmsnorm(kv_lat, g_kv)
    q = (rmsnorm(q_lat, g_q) @ w_uq).reshape(b, L, MLA_HEADS, QK_NOPE + QK_ROPE)
    q_nope, q_rope = q[..., :QK_NOPE], q[..., QK_NOPE:]
    if ctx_ckv is None:
        ckv_all, krope_all = ckv, k_rope
    else:
        cos, sin = axial_rope(L)
        q_rope = apply_rope(q_rope, cos[:, None, :], sin[:, None, :])
        krope_all = jnp.concatenate([ctx_krope, apply_rope(k_rope, cos, sin)], axis=1)
        ckv_all = jnp.concatenate([ctx_ckv, ckv], axis=1)
    lk = ckv_all.shape[1]
    k_nope = (ckv_all @ w_uk).reshape(b, lk, MLA_HEADS, QK_NOPE)
    v = (ckv_all @ w_uv).reshape(b, lk, MLA_HEADS, V_HEAD)
    attn = mla_attend(q_nope, q_rope, k_nope, krope_all, v)
    ga, gb = jnp.split(glu, 2, axis=-1)
    cv = ga * jax.nn.sigmoid(gb)
    cv = jax.nn.silu(layernorm(dwconv(cv, conv_w, conv_b), ln_g, ln_b))
    mix = jnp.concatenate([attn, cv], axis=-1) * jax.nn.silu(gate)
    return mix @ w_out, ckv, k_rope


def ssd_scan(x, dt, a_neg, bm, cm, init):
    b, L, G, E, P = x.shape
    N = bm.shape[-1]
    nc, Q = L // SSD_CHUNK, SSD_CHUNK
    f32 = jnp.float32
    xf = x.astype(f32).reshape(b, nc, Q, G, E, P)
    bf = bm.astype(f32).reshape(b, nc, Q, G, N)
    cf = cm.astype(f32).reshape(b, nc, Q, G, N)
    dtc = dt.reshape(b, nc, Q, G, E)
    a_cum = jnp.cumsum(dtc * a_neg.reshape(G, E), axis=2)
    xdt = xf * dtc[..., None]
    seg = a_cum[:, :, :, None] - a_cum[:, :, None, :]
    causal = jnp.tril(jnp.ones((Q, Q), dtype=bool))[:, :, None, None]
    decay = jnp.exp(jnp.where(causal, seg, -jnp.inf))
    cb = jnp.einsum('bclgn,bcsgn->bclsg', cf, bf)
    y_diag = jnp.einsum('bclsg,bclsge,bcsgep->bclgep', cb, decay, xdt)
    decay_end = jnp.exp(a_cum[:, :, -1:] - a_cum)
    chunk_states = jnp.einsum('bcsgn,bcsge,bcsgep->bcgepn', bf, decay_end, xdt)
    chunk_decay = jnp.exp(a_cum[:, :, -1])

    def step(s, inp):
        st, dec = inp
        return s * dec[..., None, None] + st, s

    s0 = init.astype(f32).reshape(b, G, E, P, N)
    final, prev = lax.scan(step, s0, (chunk_states.swapaxes(0, 1), chunk_decay.swapaxes(0, 1)))
    prev = prev.swapaxes(0, 1)
    y_off = jnp.einsum('bclgn,bcgepn,bclge->bclgep', cf, prev, jnp.exp(a_cum))
    y = (y_diag + y_off).reshape(b, L, G, E, P)
    return y.astype(x.dtype), final.reshape(b, G * E, P, N)


def layer_c(h, w_in, conv_w, conv_b, dt_bias, a_log, d_skip, g_norm, w_out, init_state=None):
    b, L, _ = h.shape
    u = h @ w_in
    z, xbc, dt = jnp.split(u, [SSD_INNER, SSD_INNER + SSD_CONV_CH], axis=-1)
    xbc = jax.nn.silu(dwconv(xbc, conv_w, conv_b))
    xs, bm, cm = jnp.split(xbc, [SSD_INNER, SSD_INNER + SSD_GROUPS * SSD_STATE], axis=-1)
    xs = xs.reshape(b, L, SSD_GROUPS, SSD_HPG, SSD_HEAD_DIM)
    bm = bm.reshape(b, L, SSD_GROUPS, SSD_STATE)
    cm = cm.reshape(b, L, SSD_GROUPS, SSD_STATE)
    dt = jax.nn.softplus(dt.astype(jnp.float32).reshape(b, L, 2, SSD_HEADS) + dt_bias.astype(jnp.float32))
    a_neg = -jnp.exp(a_log.astype(jnp.float32))
    if init_state is None:
        init_state = jnp.zeros((b, 2, SSD_HEADS, SSD_HEAD_DIM, SSD_STATE), jnp.float32)
    y_f, s_f = ssd_scan(xs, dt[:, :, 0], a_neg[0], bm, cm, init_state[:, 0])
    y_b, s_b = ssd_scan(jnp.flip(xs, 1), jnp.flip(dt[:, :, 1], 1), a_neg[1],
                        jnp.flip(bm, 1), jnp.flip(cm, 1), init_state[:, 1])
    y = y_f + jnp.flip(y_b, 1) + d_skip.reshape(SSD_GROUPS, SSD_HPG, 1) * xs
    y = rmsnorm(y.reshape(b, L, SSD_INNER) * jax.nn.silu(z), g_norm)
    return y @ w_out, jnp.stack([s_f, s_b], axis=1)


def setup_inputs(seed: int = 0) -> dict:
    key = jax.random.key(seed)
    ks = iter(jax.random.split(key, 40))

    def nrm(shape, s):
        return s * jax.random.normal(next(ks), shape, jnp.float32)

    def gain(shape):
        return 1.0 + nrm(shape, 0.05)

    D = D_MODEL
    dt0 = jnp.exp(jax.random.uniform(next(ks), (N_C_LAYERS, 2, SSD_HEADS), jnp.float32,
                                     math.log(1e-3), math.log(1e-1)))
    dt_bias = dt0 + jnp.log(-jnp.expm1(-dt0))
    a_log = jnp.log(jax.random.uniform(next(ks), (N_C_LAYERS, 2, SSD_HEADS), jnp.float32, 1.0, 16.0))
    return {
        'x_prompt': nrm((BATCH, SEQ, D), 1.0),
        'x_sample': nrm((DEC_BATCH, DEC_SEQ, D), 1.0),
        'cache_ckv': nrm((DEC_BATCH, N_A_LAYERS, PAST_LEN, KV_RANK), 1.0),
        'cache_krope': nrm((DEC_BATCH, N_A_LAYERS, PAST_LEN, QK_ROPE), 1.0),
        'state_ssd': nrm((DEC_BATCH, N_C_LAYERS, 2, SSD_HEADS, SSD_HEAD_DIM, SSD_STATE), 0.5),
        'c': nrm((DEC_BATCH, D), 1.0),
        'c_ctx': nrm((D,), 1.0),
        'w_mod': nrm((DEPTH, D, 3 * D), 0.5 * D ** -0.5),
        'b_mod': nrm((DEPTH, 3 * D), 0.01),
        'g_pre': gain((DEPTH, D)),
        'g_final': gain((D,)),
        'a_w_in': nrm((N_A_LAYERS, D, A_IN), D ** -0.5),
        'a_g_q': gain((N_A_LAYERS, Q_RANK)),
        'a_g_kv': gain((N_A_LAYERS, KV_RANK)),
        'a_w_uq': nrm((N_A_LAYERS, Q_RANK, MLA_HEADS * (QK_NOPE + QK_ROPE)), Q_RANK ** -0.5),
        'a_w_uk': nrm((N_A_LAYERS, KV_RANK, MLA_HEADS * QK_NOPE), KV_RANK ** -0.5),
        'a_w_uv': nrm((N_A_LAYERS, KV_RANK, MLA_HEADS * V_HEAD), KV_RANK ** -0.5),
        'a_conv_w': nrm((N_A_LAYERS, CONV_K, CONV_WIDTH), CONV_K ** -0.5),
        'a_conv_b': nrm((N_A_LAYERS, CONV_WIDTH), 0.01),
        'a_ln_g': gain((N_A_LAYERS, CONV_WIDTH)),
        'a_ln_b': nrm((N_A_LAYERS, CONV_WIDTH), 0.01),
        'a_w_out': nrm((N_A_LAYERS, A_MIX, D), A_MIX ** -0.5),
        'c_w_in': nrm((N_C_LAYERS, D, C_IN), D ** -0.5),
        'c_conv_w': nrm((N_C_LAYERS, SSD_CONV_K, SSD_CONV_CH), SSD_CONV_K ** -0.5),
        'c_conv_b': nrm((N_C_LAYERS, SSD_CONV_CH), 0.01),
        'c_dt_bias': dt_bias,
        'c_a_log': a_log,
        'c_d': gain((N_C_LAYERS, SSD_HEADS)),
        'c_g_norm': gain((N_C_LAYERS, SSD_INNER)),
        'c_w_out': nrm((N_C_LAYERS, SSD_INNER, D), SSD_INNER ** -0.5),
    }


def reference(x_prompt, x_sample, cache_ckv, cache_krope, state_ssd, c, c_ctx,
              w_mod, b_mod, g_pre, g_final,
              a_w_in, a_g_q, a_g_kv, a_w_uq, a_w_uk, a_w_uv, a_conv_w, a_conv_b, a_ln_g, a_ln_b, a_w_out,
              c_w_in, c_conv_w, c_conv_b, c_dt_bias, c_a_log, c_d, c_g_norm, c_w_out):
    xp, xs = x_prompt, x_sample
    new_ckv, new_krope, new_ssd = [], [], []
    for layer in range(DEPTH):
        i = layer // 2
        sh_p, sc_p, gt_p = modulation(c_ctx, w_mod[layer], b_mod[layer])
        sh_s, sc_s, gt_s = modulation(c, w_mod[layer], b_mod[layer])
        hp = rmsnorm(xp, g_pre[layer]) * (1.0 + sc_p) + sh_p
        hs = rmsnorm(xs, g_pre[layer]) * (1.0 + sc_s) + sh_s
        if layer % 2 == 0:
            wa = (a_w_in[i], a_g_q[i], a_g_kv[i], a_w_uq[i], a_w_uk[i], a_w_uv[i],
                  a_conv_w[i], a_conv_b[i], a_ln_g[i], a_ln_b[i], a_w_out[i])
            out_p, ckv_p, krope_p = layer_a(hp, *wa)
            out_s, _, _ = layer_a(hs, *wa, ctx_ckv=cache_ckv[:, i], ctx_krope=cache_krope[:, i])
            new_ckv.append(ckv_p)
            new_krope.append(krope_p)
        else:
            wc = (c_w_in[i], c_conv_w[i], c_conv_b[i], c_dt_bias[i], c_a_log[i], c_d[i], c_g_norm[i], c_w_out[i])
            out_p, st_p = layer_c(hp, *wc)
            out_s, _ = layer_c(hs, *wc, init_state=state_ssd[:, i])
            new_ssd.append(st_p)
        xp = xp + gt_p * out_p
        xs = xs + gt_s * out_s
    y_prompt = rmsnorm(xp, g_final)
    y_sample = rmsnorm(xs, g_final)
    new_cache_ckv = jnp.stack(new_ckv, axis=1)
    new_cache_krope = jnp.stack(new_krope, axis=1)
    new_state_ssd = jnp.stack(new_ssd, axis=1)
    return (y_prompt, y_sample, new_cache_ckv, new_cache_krope, new_state_ssd)
```

```cpp
#include <hip/hip_runtime.h>
#include <hip/hip_cooperative_groups.h>
#include <cstdio>
#include <cstdint>
#include <type_traits>
namespace cg = cooperative_groups;

#ifndef PF_C
#define PF_C 1
#endif
#ifndef PF_X
#define PF_X 0
#endif
#ifndef ONE_LAUNCH
#define ONE_LAUNCH 1
#endif

typedef unsigned short bf16_t;
typedef __attribute__((ext_vector_type(8))) short bf16x8;
typedef __attribute__((ext_vector_type(4))) short bf16x4;
typedef __attribute__((ext_vector_type(16))) float f32x16;
typedef __attribute__((ext_vector_type(4))) float f32x4;
typedef __attribute__((ext_vector_type(4))) unsigned u32x4;
typedef __attribute__((ext_vector_type(2))) unsigned u32x2;

#define DI __device__ __forceinline__
#define MFMA32(a, b, c) __builtin_amdgcn_mfma_f32_32x32x16_bf16((a), (b), (c), 0, 0, 0)

constexpr int NTHR = 256;
constexpr int LDS_BYTES = 80 * 1024;
constexpr int T_P = 4096, T_ALL = 12288;
constexpr int KVROWS = 16384;

constexpr size_t WS_WT_AIN  = 0;
constexpr size_t WS_WT_UQ   = WS_WT_AIN + 2560ull * 1024 * 2;
constexpr size_t WS_WT_UKV  = WS_WT_UQ + 768ull * 256 * 2;
constexpr size_t WS_WT_AOUT = WS_WT_UKV + 1024ull * 128 * 2;
constexpr size_t WS_WT_CIN  = WS_WT_AOUT + 1024ull * 1024 * 2;
constexpr size_t WS_WT_COUT = WS_WT_CIN + 5248ull * 1024 * 2;
constexpr size_t WS_MODP    = WS_WT_COUT + 1024ull * 2048 * 2;
constexpr size_t WS_ROPE    = WS_MODP + 8ull * 2 * 9 * 3072 * 4;
constexpr size_t WS_BAR     = WS_ROPE + 1024ull * 16 * 2 * 4;
constexpr size_t WS_R       = 24ull * 1024 * 1024;
static_assert(WS_BAR + 16384 <= WS_R, "persistent region overflow");
constexpr size_t WS_H0  = WS_R;
constexpr size_t WS_UA  = WS_H0 + 12288ull * 1024 * 2;
constexpr size_t WS_QN  = WS_UA + 12288ull * 2464 * 2;
constexpr size_t WS_Q   = WS_QN + 12288ull * 256 * 2;
constexpr size_t WS_CKV = WS_Q + 12288ull * 768 * 2;
constexpr size_t WS_KR  = WS_CKV + 16384ull * 128 * 2;
constexpr size_t WS_KN  = WS_KR + 16384ull * 32 * 2;
constexpr size_t WS_VTP = WS_KN + 16384ull * 512 * 2;
constexpr size_t WS_VTS = WS_VTP + 16ull * 8 * 64 * 256 * 2;
constexpr size_t WS_MIX = WS_VTS + 8ull * 8 * 64 * 1536 * 2;
constexpr size_t WS_A_END = WS_MIX + 12288ull * 1024 * 2;
constexpr size_t WS_Z    = WS_R;
constexpr size_t WS_XBCR = WS_Z + 12288ull * 2048 * 2;
constexpr size_t WS_H1   = WS_XBCR + 12288ull * 3072 * 2;
constexpr size_t WS_XBC  = WS_H1 + 12288ull * 1024 * 2;
constexpr size_t WS_DT   = WS_XBC + 12288ull * 3072 * 2;
constexpr size_t WS_C_END = WS_DT + 12288ull * 64 * 4;
constexpr size_t WS_YF   = WS_XBCR;
constexpr size_t WS_YB   = WS_YF + 12288ull * 2048 * 2;
constexpr size_t WS_X2   = WS_YF;
static_assert(WS_YB + 12288ull * 2048 * 2 == WS_XBC, "y alias mismatch");
constexpr size_t WS_NEED = (WS_A_END > WS_C_END ? WS_A_END : WS_C_END);
static_assert(WS_NEED <= 256ull * 1024 * 1024, "workspace too large");

constexpr size_t OUT_Y   = 0;
constexpr size_t OUT_CKV = 12288ull * 1024;
constexpr size_t OUT_KR  = OUT_CKV + 4096ull * 128;
constexpr size_t OUT_ST  = OUT_KR + 4096ull * 32;

struct Params {
  const float* in[30];
  float* out;
  unsigned char* ws;
};

typedef __bf16 hwbf2_t __attribute__((ext_vector_type(2)));
DI bf16_t f2bf(float f) { __bf16 v = (__bf16)f; return __builtin_bit_cast(bf16_t, v); }
DI float bf2f(unsigned h) { return __uint_as_float(h << 16); }
DI unsigned pk2(float a, float b) { hwbf2_t v = {(__bf16)a, (__bf16)b}; return __builtin_bit_cast(unsigned, v); }
DI float bflo(unsigned w) { return __uint_as_float(w << 16); }
DI float bfhi(unsigned w) { return __uint_as_float(w & 0xffff0000u); }
DI float fexp2(float x) { return __builtin_amdgcn_exp2f(x); }
DI float fexp(float x) { return __builtin_amdgcn_exp2f(x * 1.4426950408889634f); }
DI float frcp(float x) { return __builtin_amdgcn_rcpf(x); }
DI float siluf(float x) { return x * frcp(1.f + fexp(-x)); }
DI float sigmoidf_(float x) { return frcp(1.f + fexp(-x)); }
DI int crow(int r, int hf) { return (r & 3) + 8 * (r >> 2) + 4 * hf; }
DI float wave_sum(float v) {
#pragma unroll
  for (int o = 32; o > 0; o >>= 1) v += __shfl_xor(v, o);
  return v;
}
DI int cond_of_row(int row) { return row < T_P ? 0 : 1 + ((row - T_P) >> 10); }
DI float modp_sum(const float* modp, int layer, int cond, int j) {
  float s = 0.f;
#pragma unroll
  for (int kq = 0; kq < 8; ++kq) s += modp[((size_t)((kq * 2 + layer) * 9 + cond)) * 3072 + j];
  return s;
}

#define XB_TMO      128
#define XB_XCNT(j)  (256  + 64 * (j))
#define XB_XSUB(j)  (1280 + 64 * (j))
#define XB_XGEN(j)  (2304 + 64 * (j))
#define XB_TOP      3328
#define XB_TOPGEN   3392
#define XCD_BAR_WORDS 3456
#define XB_SPIN_CAP (1u << 22)
#define LAS __attribute__((address_space(3)))
DI unsigned xb_ld(unsigned* p) { return __hip_atomic_load(p, __ATOMIC_RELAXED, __HIP_MEMORY_SCOPE_AGENT); }
DI unsigned xb_add(unsigned* p, unsigned v) { return __hip_atomic_fetch_add(p, v, __ATOMIC_RELAXED, __HIP_MEMORY_SCOPE_AGENT); }
DI unsigned xb_xcc_id() { return (unsigned)__builtin_amdgcn_s_getreg((3 << 11) | 20) & 0xFu; }
#define XB_SPIN(cond, bar) do { unsigned _sp = 0; while (cond) { __builtin_amdgcn_s_sleep(1); \
    if ((++_sp & 255u) == 0u) { if (xb_ld(&(bar)[XB_TMO])) break; if (_sp > XB_SPIN_CAP) { atomicAdd(&(bar)[XB_TMO], 1u); break; } } } } while (0)
struct XcdBarrier { unsigned* bar; unsigned x; volatile LAS unsigned* st; };
DI XcdBarrier xcd_barrier_post(unsigned* bar, volatile LAS unsigned* st) {
  XcdBarrier b; b.bar = bar; b.x = xb_xcc_id(); b.st = st;
  if (threadIdx.x == 0) (void)xb_add(&bar[XB_XCNT(b.x)], 1u);
  return b;
}
DI void xcd_barrier_complete(unsigned* bar, unsigned x, unsigned& nloc, unsigned& nx) {
  const unsigned G = gridDim.x * gridDim.y * gridDim.z;
  unsigned sum, cnt, mine, sp = 0u;
  for (;;) {
    sum = 0u; cnt = 0u; mine = 0u;
#pragma unroll
    for (unsigned j = 0; j < 16; ++j) { const unsigned c = xb_ld(&bar[XB_XCNT(j)]); sum += c; cnt += (c > 0u) ? 1u : 0u; mine = (j == x) ? c : mine; }
    if (sum == G) break;
    __builtin_amdgcn_s_sleep(1);
    if ((++sp & 255u) == 0u) { if (xb_ld(&bar[XB_TMO])) break; if (sp > XB_SPIN_CAP) { atomicAdd(&bar[XB_TMO], 1u); break; } }
  }
  nloc = mine > 0u ? mine : 1u; nx = cnt > 0u ? cnt : 1u;
}
DI void xcd_barrier(const XcdBarrier& b) {
  asm volatile("s_waitcnt vmcnt(0)" ::: "memory");
  __syncthreads();
  if (threadIdx.x == 0) {
    unsigned* bar = b.bar;
    __builtin_amdgcn_s_waitcnt(0);
    unsigned nloc = b.st[0], nx = b.st[1];
    if (nloc == 0u) { xcd_barrier_complete(bar, b.x, nloc, nx); b.st[0] = nloc; b.st[1] = nx; }
    const unsigned old = xb_add(&bar[XB_XSUB(b.x)], 1u);
    const unsigned gen = old / nloc;
    if (old + 1u == (gen + 1u) * nloc) {
      __builtin_amdgcn_fence(__ATOMIC_RELEASE, "agent");
      asm volatile("s_waitcnt vmcnt(0)" ::: "memory");
      const unsigned og = xb_add(&bar[XB_TOP], 1u);
      const unsigned tg = og / nx;
      if (og + 1u == (tg + 1u) * nx) xb_add(&bar[XB_TOPGEN], 1u);
      else XB_SPIN(xb_ld(&bar[XB_TOPGEN]) == tg, bar);
      __builtin_amdgcn_fence(__ATOMIC_ACQUIRE, "agent");
      xb_add(&bar[XB_XGEN(b.x)], 1u);
      asm volatile("s_waitcnt vmcnt(0)" ::: "memory");
    } else {
      XB_SPIN(xb_ld(&bar[XB_XGEN(b.x)]) == gen, bar);
      __builtin_amdgcn_fence(__ATOMIC_ACQUIRE, "agent");
      asm volatile("s_waitcnt vmcnt(0)" ::: "memory");
    }
  }
  __syncthreads();
}

DI void p0_mod_item(const Params& p, int item, unsigned char* smem) {
  const int kq = item & 7, cc = (item >> 3) % 24, layer = item / 192;
  float* sSil = (float*)smem;
  float* sRed = sSil + 9 * 128;
  const int tid = threadIdx.x;
  __syncthreads();
#pragma unroll
  for (int ii = 0; ii < 5; ++ii) {
    const int i = tid + 256 * ii;
    if (i < 9 * 128) {
      const int cnd = i >> 7, k = i & 127;
      const float v = (cnd == 0) ? p.in[6][kq * 128 + k] : p.in[5][(cnd - 1) * 1024 + kq * 128 + k];
      sSil[i] = siluf(v);
    }
  }
  const int c4 = tid & 31, kg = tid >> 5;
  const float* W = p.in[7] + (size_t)layer * 1024 * 3072 + (size_t)(kq * 128) * 3072 + cc * 128 + c4 * 4;
  f32x4 w[16];
#pragma unroll
  for (int i = 0; i < 16; ++i) w[i] = *(const f32x4*)(W + (size_t)(kg + 8 * i) * 3072);
  __syncthreads();
  float acc[9][4];
#pragma unroll
  for (int c = 0; c < 9; ++c) { acc[c][0] = acc[c][1] = acc[c][2] = acc[c][3] = 0.f; }
#pragma unroll
  for (int i = 0; i < 16; ++i) {
    const int kk = kg + 8 * i;
#pragma unroll
    for (int c = 0; c < 9; ++c) {
      const float s = sSil[c * 128 + kk];
      acc[c][0] += s * w[i].x; acc[c][1] += s * w[i].y; acc[c][2] += s * w[i].z; acc[c][3] += s * w[i].w;
    }
  }
#pragma unroll
  for (int c = 0; c < 9; ++c)
#pragma unroll
    for (int j = 0; j < 4; ++j) sRed[(kg * 9 + c) * 128 + c4 * 4 + j] = acc[c][j];
  __syncthreads();
  float* modp = (float*)(p.ws + WS_MODP);
  for (int i = tid; i < 9 * 128; i += NTHR) {
    int cnd = i >> 7, col = i & 127;
    float s = 0.f;
#pragma unroll
    for (int g = 0; g < 8; ++g) s += sRed[(g * 9 + cnd) * 128 + col];
    if (kq == 0) s += p.in[8][layer * 3072 + cc * 128 + col];
    modp[((size_t)((kq * 2 + layer) * 9 + cnd)) * 3072 + cc * 128 + col] = s;
  }
}

DI void p0_tr_item(const float* W, int K, int N, int ntn, bf16_t* Wt, int tile, unsigned char* smem) {
  float* sT = (float*)smem;
  const int tid = threadIdx.x;
  const int kt = tile / ntn, nt = tile % ntn, k0 = kt * 64, n0 = nt * 64;
  __syncthreads();
#pragma unroll
  for (int i = 0; i < 4; ++i) {
    const int r = (tid >> 4) + 16 * i, c4 = (tid & 15) * 4, n = n0 + c4;
    f32x4 v = {0.f, 0.f, 0.f, 0.f};
    if (n < N) v = *(const f32x4*)(W + (size_t)(k0 + r) * N + n);
    sT[r * 65 + c4 + 0] = v.x; sT[r * 65 + c4 + 1] = v.y; sT[r * 65 + c4 + 2] = v.z; sT[r * 65 + c4 + 3] = v.w;
  }
  __syncthreads();
  const int n = tid >> 2, kc = (tid & 3) * 16;
  u32x4 o0, o1;
  o0.x = pk2(sT[(kc + 0) * 65 + n], sT[(kc + 1) * 65 + n]);   o0.y = pk2(sT[(kc + 2) * 65 + n], sT[(kc + 3) * 65 + n]);
  o0.z = pk2(sT[(kc + 4) * 65 + n], sT[(kc + 5) * 65 + n]);   o0.w = pk2(sT[(kc + 6) * 65 + n], sT[(kc + 7) * 65 + n]);
  o1.x = pk2(sT[(kc + 8) * 65 + n], sT[(kc + 9) * 65 + n]);   o1.y = pk2(sT[(kc + 10) * 65 + n], sT[(kc + 11) * 65 + n]);
  o1.z = pk2(sT[(kc + 12) * 65 + n], sT[(kc + 13) * 65 + n]); o1.w = pk2(sT[(kc + 14) * 65 + n], sT[(kc + 15) * 65 + n]);
  bf16_t* dst = Wt + (size_t)(n0 + n) * K + k0 + kc;
  *(u32x4*)dst = o0;
  *(u32x4*)(dst + 8) = o1;
}

constexpr int P0_MOD = 384, P0_TR = 976, P0_CACHE = 320, P0_ROPE = 16;
constexpr int P0_ITEMS = P0_MOD + P0_TR + P0_CACHE + P0_ROPE;

DI void phase0(const Params& p, unsigned char* smem) {
  const int tid = threadIdx.x;
  for (int it = blockIdx.x; it < P0_ITEMS; it += gridDim.x) {
    int r = it;
    if (r < P0_MOD) { p0_mod_item(p, r, smem); continue; }
    r -= P0_MOD;
    if (r < P0_TR) {
      if (r < 640) { p0_tr_item(p.in[11], 1024, 2464, 40, (bf16_t*)(p.ws + WS_WT_AIN), r, smem); continue; } r -= 640;
      if (r < 48)  { p0_tr_item(p.in[14], 256, 768, 12, (bf16_t*)(p.ws + WS_WT_UQ), r, smem); continue; } r -= 48;
      if (r < 16)  { p0_tr_item(p.in[15], 128, 512, 8, (bf16_t*)(p.ws + WS_WT_UKV), r, smem); continue; } r -= 16;
      if (r < 16)  { p0_tr_item(p.in[16], 128, 512, 8, (bf16_t*)(p.ws + WS_WT_UKV) + 512 * 128, r, smem); continue; } r -= 16;
      if (r < 256) { p0_tr_item(p.in[21], 1024, 1024, 16, (bf16_t*)(p.ws + WS_WT_AOUT), r, smem); continue; } r -= 256;
      continue;
    }
    r -= P0_TR;
    if (r < P0_CACHE) {
      if (r < 256) {
        const int idx = r * 2048 + tid * 8;
        const int b = idx >> 16, rem = idx & 65535;
        const f32x4 v0 = *(const f32x4*)(p.in[2] + idx), v1 = *(const f32x4*)(p.in[2] + idx + 4);
        u32x4 o; o.x = pk2(v0.x, v0.y); o.y = pk2(v0.z, v0.w); o.z = pk2(v1.x, v1.y); o.w = pk2(v1.z, v1.w);
        *(u32x4*)((bf16_t*)(p.ws + WS_CKV) + (size_t)(4096 + b * 1536) * 128 + rem) = o;
      } else {
        const int idx = (r - 256) * 2048 + tid * 8;
        const int b = idx >> 14, rem = idx & 16383;
        const f32x4 v0 = *(const f32x4*)(p.in[3] + idx), v1 = *(const f32x4*)(p.in[3] + idx + 4);
        u32x4 o; o.x = pk2(v0.x, v0.y); o.y = pk2(v0.z, v0.w); o.z = pk2(v1.x, v1.y); o.w = pk2(v1.z, v1.w);
        *(u32x4*)((bf16_t*)(p.ws + WS_KR) + (size_t)(4096 + b * 1536) * 32 + rem) = o;
      }
      continue;
    }
    r -= P0_CACHE;
    {
      float* rope = (float*)(p.ws + WS_ROPE);
#pragma unroll
      for (int e = 0; e < 4; ++e) {
        const int idx = r * 1024 + tid * 4 + e;
        const int pos = idx >> 4, i = idx & 15;
        const float coord = (float)((i < 8) ? (pos >> 6) : (pos & 63));
        const float inv = powf(10000.f, -(float)(i & 7) / 8.f);
        const float ang = coord * inv;
        float sn, cs; sincosf(ang, &sn, &cs);
        rope[idx * 2] = cs; rope[idx * 2 + 1] = sn;
      }
    }
  }
}

DI void convert_c_weights(const Params& p, int w, int nw, unsigned char* smem) {
  for (int r = w; r < 1824; r += nw) {
    if (r < 1312) p0_tr_item(p.in[22], 1024, 5184, 82, (bf16_t*)(p.ws + WS_WT_CIN), r, smem);
    else p0_tr_item(p.in[29], 2048, 1024, 16, (bf16_t*)(p.ws + WS_WT_COUT), r - 1312, smem);
  }
}

DI void phase_h(const Params& p, int layer, const float* xA  , const float* xB  ,
                const bf16_t* xbf  , bf16_t* H, unsigned char* smem) {
  float* sA = (float*)smem;
  float* sB = sA + 1024;
  const int tid = threadIdx.x, lane = tid & 63, wave = tid >> 6;
  const float* modp = (const float*)(p.ws + WS_MODP);
  const float* g = p.in[9] + layer * 1024;
  for (int unit = blockIdx.x; unit < T_ALL / 16; unit += gridDim.x) {
    const int row0 = unit * 16;
    const int cond = cond_of_row(row0);
    __syncthreads();
    {
      const int j = tid * 4;
      f32x4 sh = {0.f, 0.f, 0.f, 0.f}, sc = {0.f, 0.f, 0.f, 0.f};
#pragma unroll
      for (int kq = 0; kq < 8; ++kq) {
        const float* mp = modp + ((size_t)((kq * 2 + layer) * 9 + cond)) * 3072 + j;
        sh += *(const f32x4*)mp;
        sc += *(const f32x4*)(mp + 1024);
      }
      const f32x4 gg = *(const f32x4*)(g + j);
      f32x4 a = {gg.x * (1.f + sc.x), gg.y * (1.f + sc.y), gg.z * (1.f + sc.z), gg.w * (1.f + sc.w)};
      *(f32x4*)(sA + j) = a;
      *(f32x4*)(sB + j) = sh;
    }
    __syncthreads();
#pragma unroll
    for (int i = 0; i < 4; ++i) {
      const int row = row0 + wave * 4 + i;
      f32x4 v[4]; float ss = 0.f;
      if (xbf != nullptr) {
#pragma unroll
        for (int jj = 0; jj < 2; ++jj) {
          const u32x4 xw = *(const u32x4*)(xbf + (size_t)row * 1024 + lane * 8 + 512 * jj);
          v[2 * jj].x = bflo(xw.x); v[2 * jj].y = bfhi(xw.x); v[2 * jj].z = bflo(xw.y); v[2 * jj].w = bfhi(xw.y);
          v[2 * jj + 1].x = bflo(xw.z); v[2 * jj + 1].y = bfhi(xw.z); v[2 * jj + 1].z = bflo(xw.w); v[2 * jj + 1].w = bfhi(xw.w);
        }
      } else {
        const float* xr = (row < T_P) ? (xA + (size_t)row * 1024) : (xB + (size_t)(row - T_P) * 1024);
#pragma unroll
        for (int j = 0; j < 4; ++j) v[j] = *(const f32x4*)(xr + lane * 8 + 512 * (j >> 1) + 4 * (j & 1));
      }
#pragma unroll
      for (int j = 0; j < 4; ++j) ss += v[j].x * v[j].x + v[j].y * v[j].y + v[j].z * v[j].z + v[j].w * v[j].w;
      ss = wave_sum(ss);
      const float rstd = rsqrtf(ss * (1.f / 1024.f) + 1e-6f);
#pragma unroll
      for (int jj = 0; jj < 2; ++jj) {
        const int c = lane * 8 + 512 * jj;
        const f32x4 a0 = *(const f32x4*)(sA + c), b0 = *(const f32x4*)(sB + c), a1 = *(const f32x4*)(sA + c + 4), b1 = *(const f32x4*)(sB + c + 4);
        const f32x4 x0 = v[2 * jj], x1 = v[2 * jj + 1];
        u32x4 o;
        o.x = pk2(x0.x * rstd * a0.x + b0.x, x0.y * rstd * a0.y + b0.y);
        o.y = pk2(x0.z * rstd * a0.z + b0.z, x0.w * rstd * a0.w + b0.w);
        o.z = pk2(x1.x * rstd * a1.x + b1.x, x1.y * rstd * a1.y + b1.y);
        o.w = pk2(x1.z * rstd * a1.z + b1.z, x1.w * rstd * a1.w + b1.w);
        *(u32x4*)(H + (size_t)row * 1024 + c) = o;
      }
    }
  }
}

template <class Epi, int MODE = 0, bool IL = false, int KH = 1>
DI void gemm_tile(const bf16_t* __restrict__ A, int lda, const bf16_t* __restrict__ Bt, int ldb, int K,
                  int m0, int n0, unsigned char* smem, Epi& epi) {
  bf16_t* sA = (bf16_t*)smem;
  bf16_t* sB = sA + 128 * 64;
  const int tid = threadIdx.x, lane = tid & 63, wave = tid >> 6, wm = wave >> 1, wn = wave & 1, l31 = lane & 31, hf = lane >> 5;
  const int lr = tid >> 3, lc = (tid & 7) * 8;
  const bf16_t* ga = A + (size_t)(m0 + lr) * lda + lc;
  const bf16_t* gb = Bt + (size_t)(n0 + lr) * ldb + lc;
  u32x4 ra0[4], rb0[4], ra1[4], rb1[4];
  f32x16 acc[2][2];
#pragma unroll
  for (int i = 0; i < 2; ++i)
#pragma unroll
    for (int j = 0; j < 2; ++j)
#pragma unroll
      for (int r = 0; r < 16; ++r) acc[i][j][r] = 0.f;
  const int nk = K >> 6;
  constexpr int BUFE = 2 * 128 * 64;
  const int wofs = lr * 64 + (((tid & 7) ^ ((lr >> 1) & 7)) << 3);
  const int rsw = (l31 >> 1) & 7;
  const int rofA = (wm * 64 + l31) * 64, rofB = (wn * 64 + l31) * 64;
#define G_LOAD(RA, RB, KT) _Pragma("unroll") for (int i = 0; i < 4; ++i) { RA[i] = *(const u32x4*)(ga + (size_t)(32 * i) * lda + (KT) * 64); RB[i] = *(const u32x4*)(gb + (size_t)(32 * i) * ldb + (KT) * 64); }
#define G_STORE(RA, RB, SLOT) { bf16_t* nA = sA + (SLOT) * BUFE; bf16_t* nB = sB + (SLOT) * BUFE; _Pragma("unroll") for (int i = 0; i < 4; ++i) { *(u32x4*)(nA + wofs + 32 * 64 * i) = RA[i]; *(u32x4*)(nB + wofs + 32 * 64 * i) = RB[i]; } }
#define G_COMPUTE(SLOT) { const bf16_t* cA = sA + (SLOT) * BUFE; const bf16_t* cB = sB + (SLOT) * BUFE; _Pragma("unroll") for (int ks = 0; ks < 4; ++ks) { \
      const int co = (((ks * 2 + hf) ^ rsw) << 3); \
      const bf16x8 a0 = *(const bf16x8*)(cA + rofA + co); \
      const bf16x8 a1 = *(const bf16x8*)(cA + rofA + 32 * 64 + co); \
      const bf16x8 b0 = *(const bf16x8*)(cB + rofB + co); \
      const bf16x8 b1 = *(const bf16x8*)(cB + rofB + 32 * 64 + co); \
      __builtin_amdgcn_s_setprio(1); \
      acc[0][0] = MFMA32(b0, a0, acc[0][0]); acc[0][1] = MFMA32(b1, a0, acc[0][1]); \
      acc[1][0] = MFMA32(b0, a1, acc[1][0]); acc[1][1] = MFMA32(b1, a1, acc[1][1]); \
      __builtin_amdgcn_s_setprio(0); } }
#pragma unroll 1
  for (int kh = 0; kh < KH; ++kh) {
  G_LOAD(ra0, rb0, 0)
  __syncthreads();
  G_STORE(ra0, rb0, 0)
  G_LOAD(ra0, rb0, 1)
  if (nk > 2) G_LOAD(ra1, rb1, 2)
#define G_STEP(CSLOT, SSLOT, RA, RB, DO_STORE, DO_LOAD, LKT) { \
    const bf16_t* cA = sA + (CSLOT) * BUFE; const bf16_t* cB = sB + (CSLOT) * BUFE; \
    bf16_t* nA = sA + (SSLOT) * BUFE; bf16_t* nB = sB + (SSLOT) * BUFE; \
    _Pragma("unroll") for (int ks = 0; ks < 4; ++ks) { \
      const int co = (((ks * 2 + hf) ^ rsw) << 3); \
      const bf16x8 a0 = *(const bf16x8*)(cA + rofA + co); \
      const bf16x8 a1 = *(const bf16x8*)(cA + rofA + 32 * 64 + co); \
      const bf16x8 b0 = *(const bf16x8*)(cB + rofB + co); \
      const bf16x8 b1 = *(const bf16x8*)(cB + rofB + 32 * 64 + co); \
      acc[0][0] = MFMA32(b0, a0, acc[0][0]); \
      if (DO_STORE) *(u32x4*)(nA + wofs + 32 * 64 * ks) = RA[ks]; \
      acc[0][1] = MFMA32(b1, a0, acc[0][1]); \
      if (DO_LOAD) RA[ks] = *(const u32x4*)(ga + (size_t)(32 * ks) * lda + (LKT) * 64); \
      acc[1][0] = MFMA32(b0, a1, acc[1][0]); \
      if (DO_STORE) *(u32x4*)(nB + wofs + 32 * 64 * ks) = RB[ks]; \
      acc[1][1] = MFMA32(b1, a1, acc[1][1]); \
      if (DO_LOAD) RB[ks] = *(const u32x4*)(gb + (size_t)(32 * ks) * ldb + (LKT) * 64); \
    } }
  if (IL) {
  for (int kt = 0; kt < nk; kt += 2) {
    __syncthreads();
    if (kt + 3 < nk) G_STEP(0, 1, ra0, rb0, true, true, kt + 3)
    else G_STEP(0, 1, ra0, rb0, true, false, 0)
    __syncthreads();
    if (kt + 4 < nk) G_STEP(1, 0, ra1, rb1, true, true, kt + 4)
    else if (kt + 2 < nk) G_STEP(1, 0, ra1, rb1, true, false, 0)
    else G_STEP(1, 0, ra1, rb1, false, false, 0)
  }
  } else {
  for (int kt = 0; kt < nk; kt += 2) {
    __syncthreads();
    G_STORE(ra0, rb0, 1)
    if (kt + 3 < nk) G_LOAD(ra0, rb0, kt + 3)
    G_COMPUTE(0)
    __syncthreads();
    if (kt + 2 < nk) {
      G_STORE(ra1, rb1, 0)
      if (kt + 4 < nk) G_LOAD(ra1, rb1, kt + 4)
    }
    G_COMPUTE(1)
  }
  }
  ga += K; gb += K;
  }
#undef G_STEP
#undef G_LOAD
#undef G_STORE
#undef G_COMPUTE
  __syncthreads();
  float* sT = (float*)smem + wave * (64 * 68);
#pragma unroll
  for (int i = 0; i < 2; ++i)
#pragma unroll
    for (int j = 0; j < 2; ++j)
#pragma unroll
      for (int q = 0; q < 4; ++q) {
        f32x4 v = {acc[i][j][4 * q], acc[i][j][4 * q + 1], acc[i][j][4 * q + 2], acc[i][j][4 * q + 3]};
        *(f32x4*)(sT + (i * 32 + l31) * 68 + j * 32 + 8 * q + 4 * hf) = v;
      }
  epi.wave_tile(sT, m0 + wm * 64, n0 + wn * 64, lane);
}

template <int NIT = 16, class F>
DI void tile_rowwise(const float* sT, int lane, F f) {
#pragma unroll 2
  for (int it = 0; it < NIT; ++it) {
    const int row = (lane >> 4) + 4 * it, col = (lane & 15) * 4;
    const f32x4 v = *(const f32x4*)(sT + row * 68 + col);
    f(row, col, v);
  }
}

template <int NIT = 16, class F>
DI void tile_rowwise8(const float* sT, int lane, F f) {
#pragma unroll 2
  for (int it = 0; it < NIT / 2; ++it) {
    const int row = (lane >> 3) + 8 * it, col = (lane & 7) * 8;
    const f32x4 v0 = *(const f32x4*)(sT + row * 68 + col), v1 = *(const f32x4*)(sT + row * 68 + col + 4);
    u32x4 o; o.x = pk2(v0.x, v0.y); o.y = pk2(v0.z, v0.w); o.z = pk2(v1.x, v1.y); o.w = pk2(v1.z, v1.w);
    f(row, col, o);
  }
}

template <int NIT = 16, class F>
DI void tile_rowwise8f(const float* sT, int lane, F f) {
#pragma unroll 2
  for (int it = 0; it < NIT / 2; ++it) {
    const int row = (lane >> 3) + 8 * it, col = (lane & 7) * 8;
    const f32x4 v0 = *(const f32x4*)(sT + row * 68 + col), v1 = *(const f32x4*)(sT + row * 68 + col + 4);
    f(row, col, v0, v1);
  }
}

struct EpiAin {
  bf16_t* UA;
  DI void prep(int, int, unsigned char*) {}
  template <int NIT = 16>
  DI void wave_tile(const float* sT, int mr, int nc, int lane) {
    bf16_t* ua = UA;
    tile_rowwise8<NIT>(sT, lane, [=](int row, int col, u32x4 o) {
      if (nc + col < 2464) *(u32x4*)(ua + (size_t)(mr + row) * 2464 + nc + col) = o;
    });
  }
};
struct EpiQ {
  DI void after_tile(int, unsigned char*) {}
  bf16_t* Q; const float* rope;
  DI void prep(int, int, unsigned char*) {}
  DI void wave_tile(const float* sT, int mr, int nc, int lane) {
    bf16_t* q = Q; const float* rp = rope;
    tile_rowwise8f(sT, lane, [=](int row, int col, f32x4 v, f32x4 w) {
      const int grow = mr + row, gcol = nc + col;
      const int c96 = gcol % 96;
      if (grow >= T_P && c96 >= 64) {
        const int pos = (grow - T_P) & 1023, ip = (c96 - 64) >> 1;
        const f32x4 cs = *(const f32x4*)(rp + (pos * 16 + ip) * 2);
        const f32x4 cs2 = *(const f32x4*)(rp + (pos * 16 + ip + 2) * 2);
        const float a0 = v.x * cs.x - v.y * cs.y, b0 = v.x * cs.y + v.y * cs.x;
        const float a1 = v.z * cs.z - v.w * cs.w, b1 = v.z * cs.w + v.w * cs.z;
        const float a2 = w.x * cs2.x - w.y * cs2.y, b2 = w.x * cs2.y + w.y * cs2.x;
        const float a3 = w.z * cs2.z - w.w * cs2.w, b3 = w.z * cs2.w + w.w * cs2.z;
        v.x = a0; v.y = b0; v.z = a1; v.w = b1; w.x = a2; w.y = b2; w.z = a3; w.w = b3;
      }
      u32x4 o; o.x = pk2(v.x, v.y); o.y = pk2(v.z, v.w); o.z = pk2(w.x, w.y); o.w = pk2(w.z, w.w);
      *(u32x4*)(q + (size_t)grow * 768 + gcol) = o;
    });
  }
};
struct EpiKV {
  DI void after_tile(int, unsigned char*) {}
  bf16_t* KN; bf16_t* VTP; bf16_t* VTS;
  DI void prep(int, int, unsigned char*) {}
  DI void wave_tile(const float* sT, int mr, int nc, int lane) {
    if (nc < 512) {
      bf16_t* kn = KN;
      tile_rowwise8(sT, lane, [=](int row, int col, u32x4 o) {
        *(u32x4*)(kn + (size_t)(mr + row) * 512 + nc + col) = o;
      });
    } else {
      const int hh = (nc - 512) >> 6;
      bf16_t* base; int Lk, key0;
      if (mr < T_P) { const int b = mr >> 8; key0 = mr & 255; Lk = 256; base = VTP + (size_t)(b * 8 + hh) * 64 * 256; }
      else { const int r2 = mr - T_P, b = r2 / 1536; key0 = r2 - b * 1536; Lk = 1536; base = VTS + (size_t)(b * 8 + hh) * 64 * 1536; }
#pragma unroll 2
      for (int it = 0; it < 8; ++it) {
        const int d = (lane >> 3) + 8 * it, k8 = (lane & 7) * 8;
        const float* sp = sT + k8 * 68 + d;
        u32x4 o;
        o.x = pk2(sp[0], sp[68]); o.y = pk2(sp[2 * 68], sp[3 * 68]); o.z = pk2(sp[4 * 68], sp[5 * 68]); o.w = pk2(sp[6 * 68], sp[7 * 68]);
        *(u32x4*)(base + (size_t)d * Lk + key0 + k8) = o;
      }
    }
  }
};
struct EpiRes {
  const float* modp; int layer; const float* xA; const float* xB; const bf16_t* xin; bf16_t* outb; float* sGate; int gate_n0;
  DI void prep(int m0, int n0, unsigned char* smem) {
    sGate = (float*)(smem + 2 * 36864);
    const int cond = cond_of_row(m0);
    __syncthreads();
    if (threadIdx.x < 128) sGate[threadIdx.x] = modp_sum(modp, layer, cond, 2048 + n0 + threadIdx.x);
    gate_n0 = n0;
  }
  template <int NIT = 16>
  DI void wave_tile(const float* sT, int mr, int nc, int lane) {
    const float* xa = xA; const float* xb = xB; const bf16_t* xi = xin; bf16_t* o = outb; const float* sg = sGate + (nc - gate_n0);
    tile_rowwise8f<NIT>(sT, lane, [=](int row, int col, f32x4 v, f32x4 w) {
      const int grow = mr + row, gcol = nc + col;
      const f32x4 g0 = *(const f32x4*)(sg + col), g1 = *(const f32x4*)(sg + col + 4);
      f32x4 x0, x1;
      if (xi != nullptr) {
        const u32x4 xw = *(const u32x4*)(xi + (size_t)grow * 1024 + gcol);
        x0.x = bflo(xw.x); x0.y = bfhi(xw.x); x0.z = bflo(xw.y); x0.w = bfhi(xw.y);
        x1.x = bflo(xw.z); x1.y = bfhi(xw.z); x1.z = bflo(xw.w); x1.w = bfhi(xw.w);
      } else {
        const float* xp = (grow < T_P) ? (xa + (size_t)grow * 1024 + gcol) : (xb + (size_t)(grow - T_P) * 1024 + gcol);
        x0 = *(const f32x4*)xp; x1 = *(const f32x4*)(xp + 4);
      }
      u32x4 r;
      r.x = pk2(x0.x + g0.x * v.x, x0.y + g0.y * v.y); r.y = pk2(x0.z + g0.z * v.z, x0.w + g0.w * v.w);
      r.z = pk2(x1.x + g1.x * w.x, x1.y + g1.y * w.y); r.w = pk2(x1.z + g1.z * w.z, x1.w + g1.w * w.w);
      *(u32x4*)(o + (size_t)grow * 1024 + gcol) = r;
    });
  }
};
struct EpiCin {
  bf16_t* Z; bf16_t* XBCR; float* DT; const float* dtb;
  DI void prep(int, int, unsigned char*) {}
  template <int NIT = 16>
  DI void wave_tile(const float* sT, int mr, int nc, int lane) {
    if (nc < 2048) {
      bf16_t* z = Z;
      tile_rowwise8<NIT>(sT, lane, [=](int row, int col, u32x4 o) {
        *(u32x4*)(z + (size_t)(mr + row) * 2048 + nc + col) = o;
      });
    } else if (nc < 5120) {
      bf16_t* x = XBCR;
      tile_rowwise8<NIT>(sT, lane, [=](int row, int col, u32x4 o) {
        *(u32x4*)(x + (size_t)(mr + row) * 3072 + (nc - 2048) + col) = o;
      });
    } else if (nc < 5184) {
      float* dt = DT; const float* b = dtb;
      tile_rowwise<NIT>(sT, lane, [=](int row, int col, f32x4 v) {
        const int c = nc - 5120 + col;
        const f32x4 bias = *(const f32x4*)(b + c);
        f32x4 r;
        { const float x = v.x + bias.x; r.x = fmaxf(x, 0.f) + log1pf(__expf(-fabsf(x))); }
        { const float x = v.y + bias.y; r.y = fmaxf(x, 0.f) + log1pf(__expf(-fabsf(x))); }
        { const float x = v.z + bias.z; r.z = fmaxf(x, 0.f) + log1pf(__expf(-fabsf(x))); }
        { const float x = v.w + bias.w; r.w = fmaxf(x, 0.f) + log1pf(__expf(-fabsf(x))); }
        *(f32x4*)(dt + (size_t)(mr + row) * 64 + c) = r;
      });
    }
  }
};

template <bool IL = false, int KH = 1, class Epi>
DI void gemm_phase(const bf16_t* A, int lda, const bf16_t* Bt, int ldb, int K, int mtiles, int ntiles, unsigned char* smem, Epi& epi) {
  if ((gridDim.x & 7) == 0 && (mtiles & 7) == 0) {
    const int xcd = blockIdx.x & 7, j = blockIdx.x >> 3, nb = gridDim.x >> 3, mper = mtiles >> 3;
    for (int idx = j; idx < mper * ntiles; idx += nb) {
      const int nt = idx / mper, mt = xcd * mper + (idx - nt * mper);
      epi.prep(mt * 128, nt * 128, smem);
      gemm_tile<Epi, 0, IL, KH>(A, lda, Bt, ldb, K, mt * 128, nt * 128, smem, epi);
    }
  } else {
    for (int t = blockIdx.x; t < mtiles * ntiles; t += gridDim.x) {
      const int mt = t / ntiles, nt = t - mt * ntiles;
      epi.prep(mt * 128, nt * 128, smem);
      gemm_tile<Epi, 0, IL, KH>(A, lda, Bt, ldb, K, mt * 128, nt * 128, smem, epi);
    }
  }
}

template <class Epi>
DI void gemm_tile_big(const bf16_t* __restrict__ A, int lda, const bf16_t* __restrict__ Bt, int ldb, int K,
                      int m0, int n0, unsigned char* smem, Epi& epi) {
  bf16_t* sA = (bf16_t*)smem;
  bf16_t* sB = sA + 256 * 32;
  constexpr int BUFE = 384 * 32;
  const int tid = threadIdx.x, lane = tid & 63, wave = tid >> 6, wm = wave >> 1, wn = wave & 1, l31 = lane & 31, hf = lane >> 5;
  const int lr = tid >> 2, lch = tid & 3;
  const bf16_t* ga = A + (size_t)(m0 + lr) * lda + lch * 8;
  const bf16_t* gb = Bt + (size_t)(n0 + lr) * ldb + lch * 8;
  const int wofs = lr * 32 + ((lch ^ ((lr >> 2) & 3)) << 3);
  const int rsw = (l31 >> 2) & 3;
  const int rofA = (wm * 128 + l31) * 32, rofB = (wn * 64 + l31) * 32;
  u32x4 ra0[4], rb0[2], ra1[4], rb1[2];
  f32x16 acc[4][2];
#pragma unroll
  for (int i = 0; i < 4; ++i)
#pragma unroll
    for (int j = 0; j < 2; ++j)
#pragma unroll
      for (int r = 0; r < 16; ++r) acc[i][j][r] = 0.f;
  const int nk = K >> 5;
#define GB_LOAD(RA, RB, KT) { _Pragma("unroll") for (int i = 0; i < 4; ++i) RA[i] = *(const u32x4*)(ga + (size_t)(64 * i) * lda + (KT) * 32); \
                              _Pragma("unroll") for (int i = 0; i < 2; ++i) RB[i] = *(const u32x4*)(gb + (size_t)(64 * i) * ldb + (KT) * 32); }
#define GB_STORE(RA, RB, SLOT) { bf16_t* nA = sA + (SLOT) * BUFE; bf16_t* nB = sB + (SLOT) * BUFE; \
                              _Pragma("unroll") for (int i = 0; i < 4; ++i) *(u32x4*)(nA + wofs + 64 * 32 * i) = RA[i]; \
                              _Pragma("unroll") for (int i = 0; i < 2; ++i) *(u32x4*)(nB + wofs + 64 * 32 * i) = RB[i]; }
#define GB_COMPUTE(SLOT) { const bf16_t* cA = sA + (SLOT) * BUFE; const bf16_t* cB = sB + (SLOT) * BUFE; _Pragma("unroll") for (int ks = 0; ks < 2; ++ks) { \
      const int co = (((ks * 2 + hf) ^ rsw) << 3); \
      bf16x8 af[4], bfr[2]; \
      _Pragma("unroll") for (int i = 0; i < 4; ++i) af[i] = *(const bf16x8*)(cA + rofA + 32 * 32 * i + co); \
      _Pragma("unroll") for (int j = 0; j < 2; ++j) bfr[j] = *(const bf16x8*)(cB + rofB + 32 * 32 * j + co); \
      __builtin_amdgcn_s_setprio(1); \
      _Pragma("unroll") for (int i = 0; i < 4; ++i) { acc[i][0] = MFMA32(bfr[0], af[i], acc[i][0]); acc[i][1] = MFMA32(bfr[1], af[i], acc[i][1]); } \
      __builtin_amdgcn_s_setprio(0); } }
  GB_LOAD(ra0, rb0, 0)
  __syncthreads();
  GB_STORE(ra0, rb0, 0)
  GB_LOAD(ra0, rb0, 1)
  if (nk > 2) GB_LOAD(ra1, rb1, 2)
  for (int kt = 0; kt < nk; kt += 2) {
    __syncthreads();
    GB_STORE(ra0, rb0, 1)
    if (kt + 3 < nk) GB_LOAD(ra0, rb0, kt + 3)
    GB_COMPUTE(0)
    __syncthreads();
    if (kt + 2 < nk) {
      GB_STORE(ra1, rb1, 0)
      if (kt + 4 < nk) GB_LOAD(ra1, rb1, kt + 4)
    }
    GB_COMPUTE(1)
  }
#undef GB_LOAD
#undef GB_STORE
#undef GB_COMPUTE
  __syncthreads();
  float* sT = (float*)smem + wave * (32 * 68);
#pragma unroll
  for (int i = 0; i < 4; ++i) {
#pragma unroll
    for (int j = 0; j < 2; ++j)
#pragma unroll
      for (int q = 0; q < 4; ++q) {
        f32x4 v = {acc[i][j][4 * q], acc[i][j][4 * q + 1], acc[i][j][4 * q + 2], acc[i][j][4 * q + 3]};
        *(f32x4*)(sT + l31 * 68 + j * 32 + 8 * q + 4 * hf) = v;
      }
    epi.template wave_tile<8>(sT, m0 + wm * 128 + i * 32, n0 + wn * 64, lane);
  }
}

template <class Epi>
DI void gemm_phase_big(const bf16_t* A, int lda, const bf16_t* Bt, int ldb, int K, int mtiles, int ntiles, unsigned char* smem, Epi& epi) {
  if ((gridDim.x & 7) == 0 && (mtiles & 7) == 0) {
    const int xcd = blockIdx.x & 7, j = blockIdx.x >> 3, nb = gridDim.x >> 3, mper = mtiles >> 3;
    for (int idx = j; idx < mper * ntiles; idx += nb) {
      const int nt = idx / mper, mt = xcd * mper + (idx - nt * mper);
      epi.prep(mt * 256, nt * 128, smem);
      gemm_tile_big(A, lda, Bt, ldb, K, mt * 256, nt * 128, smem, epi);
    }
  } else {
    for (int t = blockIdx.x; t < mtiles * ntiles; t += gridDim.x) {
      const int mt = t / ntiles, nt = t - mt * ntiles;
      epi.prep(mt * 256, nt * 128, smem);
      gemm_tile_big(A, lda, Bt, ldb, K, mt * 256, nt * 128, smem, epi);
    }
  }
}

DI float reduce16(const float (&v)[16], int lane) {
  const bool b5 = (lane & 32) != 0, b4 = (lane & 16) != 0, b3 = (lane & 8) != 0, b2 = (lane & 4) != 0;
  float a[8], b[4], c[2];
#pragma unroll
  for (int i = 0; i < 8; ++i) { const float send = b5 ? v[i] : v[i + 8], keep = b5 ? v[i + 8] : v[i]; a[i] = keep + __shfl_xor(send, 32); }
#pragma unroll
  for (int i = 0; i < 4; ++i) { const float send = b4 ? a[i] : a[i + 4], keep = b4 ? a[i + 4] : a[i]; b[i] = keep + __shfl_xor(send, 16); }
#pragma unroll
  for (int i = 0; i < 2; ++i) { const float send = b3 ? b[i] : b[i + 2], keep = b3 ? b[i + 2] : b[i]; c[i] = keep + __shfl_xor(send, 8); }
  const float send = b2 ? c[0] : c[1], keep = b2 ? c[1] : c[0];
  float d = keep + __shfl_xor(send, 4);
  d += __shfl_xor(d, 2);
  d += __shfl_xor(d, 1);
  return d;
}

DI void phase3(const Params& p, unsigned char* smem) {
  const int tid = threadIdx.x, lane = tid & 63, wave = tid >> 6;
  const bf16_t* UA = (const bf16_t*)(p.ws + WS_UA);
  bf16_t* QN = (bf16_t*)(p.ws + WS_QN);
  bf16_t* CKV = (bf16_t*)(p.ws + WS_CKV);
  bf16_t* KR = (bf16_t*)(p.ws + WS_KR);
  bf16_t* MIX = (bf16_t*)(p.ws + WS_MIX);
  const float* rope = (const float*)(p.ws + WS_ROPE);
  const float* gq = p.in[12];
  const float* gkv = p.in[13];
  auto proc = [&](int row, u32x2 wq, unsigned wkv, unsigned wkr) {
    {
      const float a = bflo(wq.x), b = bfhi(wq.x), c = bflo(wq.y), d = bfhi(wq.y);
      const float ss = wave_sum(a * a + b * b + c * c + d * d);
      const float rstd = rsqrtf(ss * (1.f / 256.f) + 1e-6f);
      const f32x4 g = *(const f32x4*)(gq + lane * 4);
      u32x2 o; o.x = pk2(a * rstd * g.x, b * rstd * g.y); o.y = pk2(c * rstd * g.z, d * rstd * g.w);
      *(u32x2*)(QN + (size_t)row * 256 + lane * 4) = o;
    }
    int kvrow; int pos = 0;
    if (row < T_P) kvrow = row;
    else { const int r2 = row - T_P; const int b = r2 >> 10; pos = r2 & 1023; kvrow = T_P + b * 1536 + 512 + pos; }
    {
      const float a = bflo(wkv), b = bfhi(wkv);
      const float ss = wave_sum(a * a + b * b);
      const float rstd = rsqrtf(ss * (1.f / 128.f) + 1e-6f);
      const float oa = a * rstd * gkv[lane * 2], ob = b * rstd * gkv[lane * 2 + 1];
      *(unsigned*)(CKV + (size_t)kvrow * 128 + lane * 2) = pk2(oa, ob);
      if (row < T_P) { float* o = p.out + OUT_CKV + (size_t)row * 128 + lane * 2; o[0] = oa; o[1] = ob; }
    }
    if (lane < 16) {
      float a = bflo(wkr), b = bfhi(wkr);
      if (row < T_P) {
        float* o = p.out + OUT_KR + (size_t)row * 32 + lane * 2; o[0] = a; o[1] = b;
      } else {
        const float cs = rope[(pos * 16 + lane) * 2], sn = rope[(pos * 16 + lane) * 2 + 1];
        const float na = a * cs - b * sn, nb = a * sn + b * cs;
        a = na; b = nb;
      }
      *(unsigned*)(KR + (size_t)kvrow * 32 + lane * 2) = pk2(a, b);
    }
  };
  {
    int rbeg = 0, rend = T_ALL, nw = gridDim.x * 4, w0 = blockIdx.x * 4 + wave;
    if (gridDim.x == 512) {
      if (blockIdx.x >= 384) { rbeg = 0; rend = 6400; nw = 128 * 4; w0 = (blockIdx.x - 384) * 4 + wave; }
      else { rbeg = 6400; rend = T_ALL; nw = 384 * 4; }
    }
    for (int row = rbeg + w0; row < rend; row += 2 * nw) {
      const int row2 = row + nw; const bool has2 = row2 < rend;
      const bf16_t* u0 = UA + (size_t)row * 2464;
      const bf16_t* u1 = UA + (size_t)(has2 ? row2 : row) * 2464;
      const u32x2 wq0 = *(const u32x2*)(u0 + lane * 4), wq1 = *(const u32x2*)(u1 + lane * 4);
      const unsigned wkv0 = *(const unsigned*)(u0 + 256 + lane * 2), wkv1 = *(const unsigned*)(u1 + 256 + lane * 2);
      const unsigned wkr0 = *(const unsigned*)(u0 + 384 + (lane & 15) * 2), wkr1 = *(const unsigned*)(u1 + 384 + (lane & 15) * 2);
      proc(row, wq0, wkv0, wkr0);
      if (has2) proc(row2, wq1, wkv1, wkr1);
    }
  }
  bf16_t* sCv = (bf16_t*)smem;
  float* sRed = (float*)(smem + 62 * 512 * 2);
  const float* cw = p.in[17];
  const float* cb = p.in[18];
  const float* lg = p.in[19];
  const float* lb = p.in[20];
  for (int tile = blockIdx.x; tile < T_ALL / 32; tile += gridDim.x) {
    const int t0 = tile * 32;
    int s0, s1;
    if (t0 < T_P) { s0 = t0 & ~255; s1 = s0 + 256; } else { s0 = T_P + ((t0 - T_P) & ~1023); s1 = s0 + 1024; }
    __syncthreads();
#pragma unroll 8
    for (int ch = tid; ch < 62 * 64; ch += NTHR) {
      const int r = ch >> 6, c8 = (ch & 63) * 8;
      const int row = t0 - 15 + r;
      u32x4 o = {0u, 0u, 0u, 0u};
      if (row >= s0 && row < s1) {
        const u32x4 ga = *(const u32x4*)(UA + (size_t)row * 2464 + 416 + c8);
        const u32x4 gb = *(const u32x4*)(UA + (size_t)row * 2464 + 928 + c8);
        o.x = pk2(bflo(ga.x) * sigmoidf_(bflo(gb.x)), bfhi(ga.x) * sigmoidf_(bfhi(gb.x)));
        o.y = pk2(bflo(ga.y) * sigmoidf_(bflo(gb.y)), bfhi(ga.y) * sigmoidf_(bfhi(gb.y)));
        o.z = pk2(bflo(ga.z) * sigmoidf_(bflo(gb.z)), bfhi(ga.z) * sigmoidf_(bfhi(gb.z)));
        o.w = pk2(bflo(ga.w) * sigmoidf_(bflo(gb.w)), bfhi(ga.w) * sigmoidf_(bfhi(gb.w)));
      }
      *(u32x4*)(sCv + r * 512 + c8) = o;
    }
    __syncthreads();
    const int c = tid * 2;
    float wk0[31], wk1[31];
#pragma unroll
    for (int k = 0; k < 31; ++k) { const float2 w = *(const float2*)(cw + k * 512 + c); wk0[k] = w.x; wk1[k] = w.y; }
#pragma unroll 1
    for (int half = 0; half < 2; ++half) {
      const int tb = half * 16;
      float acc0[16], acc1[16];
      {
        const float b0 = cb[c], b1 = cb[c + 1];
#pragma unroll
        for (int t = 0; t < 16; ++t) { acc0[t] = b0; acc1[t] = b1; }
      }
#pragma unroll
      for (int rho = 0; rho < 46; ++rho) {
        const unsigned w = *(const unsigned*)(sCv + (tb + rho) * 512 + c);
        const float x0 = bflo(w), x1 = bfhi(w);
#pragma unroll
        for (int t = 0; t < 16; ++t) {
          const int k = rho - t;
          if (k >= 0 && k < 31) { acc0[t] += x0 * wk0[k]; acc1[t] += x1 * wk1[k]; }
        }
      }
      __syncthreads();
      const int tsel = ((lane >> 5) & 1) * 8 + ((lane >> 4) & 1) * 4 + ((lane >> 3) & 1) * 2 + ((lane >> 2) & 1);
      {
        float v[16];
#pragma unroll
        for (int t = 0; t < 16; ++t) v[t] = acc0[t] + acc1[t];
        const float tot = reduce16(v, lane);
        if ((lane & 3) == 0) sRed[tsel * 4 + wave] = tot;
      }
      __syncthreads();
      {
        float v[16];
#pragma unroll
        for (int t = 0; t < 16; ++t) {
          const float mean = (sRed[t * 4] + sRed[t * 4 + 1] + sRed[t * 4 + 2] + sRed[t * 4 + 3]) * (1.f / 512.f);
          acc0[t] -= mean; acc1[t] -= mean;
          v[t] = acc0[t] * acc0[t] + acc1[t] * acc1[t];
        }
        const float tot = reduce16(v, lane);
        if ((lane & 3) == 0) sRed[128 + tsel * 4 + wave] = tot;
      }
      __syncthreads();
      {
        const float g0 = lg[c], g1 = lg[c + 1], bb0 = lb[c], bb1 = lb[c + 1];
        __syncthreads();
#pragma unroll
        for (int t = 0; t < 16; ++t) {
          const float var = (sRed[128 + t * 4] + sRed[128 + t * 4 + 1] + sRed[128 + t * 4 + 2] + sRed[128 + t * 4 + 3]) * (1.f / 512.f);
          const float rstd = rsqrtf(var + 1e-6f);
          *(unsigned*)(sCv + (tb + t) * 512 + c) = pk2(siluf(acc0[t] * rstd * g0 + bb0), siluf(acc1[t] * rstd * g1 + bb1));
        }
        __syncthreads();
#pragma unroll
        for (int i = 0; i < 4; ++i) {
          const int ch = tid + 256 * i; const int r = ch >> 6, c8 = (ch & 63) * 8;
          const int row = t0 + tb + r;
          const u32x4 yv = *(const u32x4*)(sCv + (tb + r) * 512 + c8);
          const u32x4 gw = *(const u32x4*)(UA + (size_t)row * 2464 + 1440 + 512 + c8);
          u32x4 o;
          o.x = pk2(bflo(yv.x) * siluf(bflo(gw.x)), bfhi(yv.x) * siluf(bfhi(gw.x)));
          o.y = pk2(bflo(yv.y) * siluf(bflo(gw.y)), bfhi(yv.y) * siluf(bfhi(gw.y)));
          o.z = pk2(bflo(yv.z) * siluf(bflo(gw.z)), bfhi(yv.z) * siluf(bfhi(gw.z)));
          o.w = pk2(bflo(yv.w) * siluf(bflo(gw.w)), bfhi(yv.w) * siluf(bfhi(gw.w)));
          *(u32x4*)(MIX + (size_t)row * 1024 + 512 + c8) = o;
        }
      }
    }
  }
}

DI void phase_attn(const Params& p, unsigned char* smem) {
  const int tid = threadIdx.x, lane = tid & 63, wave = tid >> 6, l31 = lane & 31, hf = lane >> 5;
  constexpr int ATT_SLOT = 64 * 104 + 64 * 72;
  bf16_t* sK0 = (bf16_t*)smem;
  bf16_t* sV0 = sK0 + 64 * 104;
  const bf16_t* Q = (const bf16_t*)(p.ws + WS_Q);
  const bf16_t* KN = (const bf16_t*)(p.ws + WS_KN);
  const bf16_t* KR = (const bf16_t*)(p.ws + WS_KR);
  const bf16_t* UA = (const bf16_t*)(p.ws + WS_UA);
  bf16_t* MIX = (bf16_t*)(p.ws + WS_MIX);
  const float SC = 0.10206207261596577f * 1.4426950408889634f;
  const bool xa = (gridDim.x & 7) == 0;
  const int axcd = blockIdx.x & 7, aper = xa ? 96 : 768, anb = xa ? (gridDim.x >> 3) : gridDim.x;
  for (int idx = xa ? (blockIdx.x >> 3) : blockIdx.x; idx < aper; idx += anb) {
    const int item = xa ? ((idx < 64) ? (axcd * 64 + idx) : (512 + axcd * 32 + (idx - 64))) : idx;
    int h, Lk, tok0, kvrow0; const bf16_t* vt;
    if (item < 512) {
      const int b = item >> 6; h = (item >> 3) & 7; const int qb = item & 7; Lk = 1536;
      tok0 = T_P + b * 1024 + qb * 128; kvrow0 = T_P + b * 1536;
      vt = (const bf16_t*)(p.ws + WS_VTS) + (size_t)(b * 8 + h) * 64 * 1536;
    } else {
      const int it = item - 512; const int b = it >> 4; h = (it >> 1) & 7; const int qb = it & 1; Lk = 256;
      tok0 = b * 256 + qb * 128; kvrow0 = b * 256;
      vt = (const bf16_t*)(p.ws + WS_VTP) + (size_t)(b * 8 + h) * 64 * 256;
    }
    const int token = tok0 + wave * 32 + l31;
    bf16x8 qf[6];
#pragma unroll
    for (int ks = 0; ks < 6; ++ks) qf[ks] = *(const bf16x8*)(Q + (size_t)token * 768 + h * 96 + ks * 16 + hf * 8);
    f32x16 O[2];
#pragma unroll
    for (int r = 0; r < 16; ++r) { O[0][r] = 0.f; O[1][r] = 0.f; }
    float m_run = -INFINITY, lsum = 0.f;
    u32x4 rkA[3], rvA[2], rkB[3], rvB[2];
    const int nkt = Lk >> 6;
    auto gload = [&](int kt, u32x4 (&rk)[3], u32x4 (&rv)[2]) {
      const int k0 = kt * 64;
#pragma unroll
      for (int i = 0; i < 3; ++i) {
        const int c = tid + 256 * i; const int key = c / 12, part = c - key * 12;
        const size_t kr = (size_t)(kvrow0 + k0 + key);
        rk[i] = (part < 8) ? *(const u32x4*)(KN + kr * 512 + h * 64 + part * 8) : *(const u32x4*)(KR + kr * 32 + (part - 8) * 8);
      }
#pragma unroll
      for (int i = 0; i < 2; ++i) {
        const int c = tid + 256 * i; const int d = c >> 3, part = c & 7;
        rv[i] = *(const u32x4*)(vt + (size_t)d * Lk + k0 + part * 8);
      }
    };
    auto lstore = [&](int slot, u32x4 (&rk)[3], u32x4 (&rv)[2]) {
      bf16_t* nK = sK0 + slot * ATT_SLOT;
      bf16_t* nV = sV0 + slot * ATT_SLOT;
#pragma unroll
      for (int i = 0; i < 3; ++i) { const int c = tid + 256 * i; const int key = c / 12, part = c - key * 12; *(u32x4*)(nK + key * 104 + part * 8) = rk[i]; }
#pragma unroll
      for (int i = 0; i < 2; ++i) { const int c = tid + 256 * i; const int d = c >> 3, part = c & 7; *(u32x4*)(nV + d * 72 + part * 8) = rv[i]; }
    };
    auto compute = [&](int slot) {
      const bf16_t* sK = sK0 + slot * ATT_SLOT;
      const bf16_t* sV = sV0 + slot * ATT_SLOT;
      f32x16 S[2];
#pragma unroll
      for (int sub = 0; sub < 2; ++sub) {
#pragma unroll
        for (int r = 0; r < 16; ++r) S[sub][r] = 0.f;
#pragma unroll
        for (int ks = 0; ks < 6; ++ks) {
          const bf16x8 a = *(const bf16x8*)(sK + (sub * 32 + l31) * 104 + ks * 16 + hf * 8);
          S[sub] = MFMA32(a, qf[ks], S[sub]);
        }
      }
      float mx = -INFINITY;
#pragma unroll
      for (int r = 0; r < 16; ++r) { mx = fmaxf(mx, S[0][r]); mx = fmaxf(mx, S[1][r]); }
      mx = fmaxf(mx, __shfl_xor(mx, 32));
      const float m_new = fmaxf(m_run, mx * SC);
      const float alpha = fexp2(m_run - m_new);
      m_run = m_new;
      float ps = 0.f;
#pragma unroll
      for (int sub = 0; sub < 2; ++sub)
#pragma unroll
        for (int r = 0; r < 16; ++r) { const float e = fexp2(S[sub][r] * SC - m_new); S[sub][r] = e; ps += e; }
      lsum = lsum * alpha + ps;
#pragma unroll
      for (int r = 0; r < 16; ++r) { O[0][r] *= alpha; O[1][r] *= alpha; }
#pragma unroll
      for (int sub = 0; sub < 2; ++sub)
#pragma unroll
        for (int s2 = 0; s2 < 2; ++s2) {
          u32x4 pw;
          pw.x = pk2(S[sub][8 * s2 + 0], S[sub][8 * s2 + 1]); pw.y = pk2(S[sub][8 * s2 + 2], S[sub][8 * s2 + 3]);
          pw.z = pk2(S[sub][8 * s2 + 4], S[sub][8 * s2 + 5]); pw.w = pk2(S[sub][8 * s2 + 6], S[sub][8 * s2 + 7]);
          const bf16x8 pf = __builtin_bit_cast(bf16x8, pw);
#pragma unroll
          for (int dt = 0; dt < 2; ++dt) {
            const bf16_t* vp = sV + (dt * 32 + l31) * 72 + sub * 32 + s2 * 16 + hf * 4;
            const u32x2 lo = *(const u32x2*)vp, hi = *(const u32x2*)(vp + 8);
            u32x4 aw; aw.x = lo.x; aw.y = lo.y; aw.z = hi.x; aw.w = hi.y;
            O[dt] = MFMA32(__builtin_bit_cast(bf16x8, aw), pf, O[dt]);
          }
        }
    };
    gload(0, rkA, rvA);
    __syncthreads();
    lstore(0, rkA, rvA);
    gload(1, rkA, rvA);
    gload(2, rkB, rvB);
    for (int kt = 0; kt < nkt; kt += 2) {
      __syncthreads();
      compute(0);
      lstore(1, rkA, rvA);
      if (kt + 3 < nkt) gload(kt + 3, rkA, rvA);
      __syncthreads();
      compute(1);
      if (kt + 2 < nkt) { lstore(0, rkB, rvB); if (kt + 4 < nkt) gload(kt + 4, rkB, rvB); }
    }
    lsum += __shfl_xor(lsum, 32);
    const float inv = 1.f / lsum;
    __syncthreads();
    {
      float* sT = (float*)smem + wave * (32 * 68);
#pragma unroll
      for (int dt = 0; dt < 2; ++dt)
#pragma unroll
        for (int q4 = 0; q4 < 4; ++q4) {
          f32x4 v = {O[dt][4 * q4] * inv, O[dt][4 * q4 + 1] * inv, O[dt][4 * q4 + 2] * inv, O[dt][4 * q4 + 3] * inv};
          *(f32x4*)(sT + l31 * 68 + dt * 32 + 8 * q4 + 4 * hf) = v;
        }
      const int trow0 = tok0 + wave * 32;
      tile_rowwise8f<8>(sT, lane, [=](int row, int col, f32x4 v, f32x4 w) {
        const size_t tk = (size_t)(trow0 + row);
        const u32x4 gw = *(const u32x4*)(UA + tk * 2464 + 1440 + h * 64 + col);
        u32x4 o;
        o.x = pk2(v.x * siluf(bflo(gw.x)), v.y * siluf(bfhi(gw.x)));
        o.y = pk2(v.z * siluf(bflo(gw.y)), v.w * siluf(bfhi(gw.y)));
        o.z = pk2(w.x * siluf(bflo(gw.z)), w.y * siluf(bfhi(gw.z)));
        o.w = pk2(w.z * siluf(bflo(gw.w)), w.w * siluf(bfhi(gw.w)));
        *(u32x4*)(MIX + tk * 1024 + h * 64 + col) = o;
      });
    }
  }
}

DI void phase_conv5(const Params& p) {
  const int tid = threadIdx.x;
  const bf16_t* XR = (const bf16_t*)(p.ws + WS_XBCR);
  bf16_t* XC = (bf16_t*)(p.ws + WS_XBC);
  const float* cw = p.in[23];
  const float* cb = p.in[24];
  const int c = tid * 12;
  float w[5][12], bias[12];
#pragma unroll
  for (int k = 0; k < 5; ++k)
#pragma unroll
    for (int q = 0; q < 3; ++q) {
      const f32x4 a = *(const f32x4*)(cw + k * 3072 + c + 4 * q);
      w[k][4 * q] = a.x; w[k][4 * q + 1] = a.y; w[k][4 * q + 2] = a.z; w[k][4 * q + 3] = a.w;
    }
#pragma unroll
  for (int q = 0; q < 3; ++q) {
    const f32x4 a = *(const f32x4*)(cb + c + 4 * q);
    bias[4 * q] = a.x; bias[4 * q + 1] = a.y; bias[4 * q + 2] = a.z; bias[4 * q + 3] = a.w;
  }
  for (int tile = blockIdx.x; tile < T_ALL / 8; tile += gridDim.x) {
    const int t0 = tile * 8;
    int s0, s1;
    if (t0 < T_P) { s0 = t0 & ~255; s1 = s0 + 256; } else { s0 = T_P + ((t0 - T_P) & ~1023); s1 = s0 + 1024; }
    unsigned raw[12][6];
#pragma unroll
    for (int r = 0; r < 12; ++r) {
      const int row = t0 - 2 + r;
      u32x2 u0 = {0u, 0u}; u32x4 u1 = {0u, 0u, 0u, 0u};
      if (row >= s0 && row < s1) {
        const u32x2* sp = (const u32x2*)(XR + (size_t)row * 3072 + c);
        u0 = sp[0]; const u32x2 m = sp[1], h2 = sp[2];
        u1.x = m.x; u1.y = m.y; u1.z = h2.x; u1.w = h2.y;
      }
      raw[r][0] = u0.x; raw[r][1] = u0.y; raw[r][2] = u1.x; raw[r][3] = u1.y; raw[r][4] = u1.z; raw[r][5] = u1.w;
    }
#pragma unroll
    for (int t = 0; t < 8; ++t) {
      float a[12];
#pragma unroll
      for (int e = 0; e < 12; ++e) a[e] = bias[e];
#pragma unroll
      for (int k = 0; k < 5; ++k)
#pragma unroll
        for (int d = 0; d < 6; ++d) {
          const unsigned u = raw[t + k][d];
          a[2 * d] += bflo(u) * w[k][2 * d]; a[2 * d + 1] += bfhi(u) * w[k][2 * d + 1];
        }
      u32x2 o[3];
#pragma unroll
      for (int q = 0; q < 3; ++q) { o[q].x = pk2(siluf(a[4 * q]), siluf(a[4 * q + 1])); o[q].y = pk2(siluf(a[4 * q + 2]), siluf(a[4 * q + 3])); }
      u32x2* dp = (u32x2*)(XC + (size_t)(t0 + t) * 3072 + c);
      dp[0] = o[0]; dp[1] = o[1]; dp[2] = o[2];
    }
  }
}

DI void phase_scan(const Params& p, unsigned char* smem) {
  const int tid = threadIdx.x, lane = tid & 63, wave = tid >> 6, l31 = lane & 31, hf = lane >> 5;
  bf16_t* sB = (bf16_t*)smem;
  bf16_t* sXT = sB + 128 * 136;
  bf16_t* sS = sXT + 64 * 136;
  float* sAc = (float*)(sS + 64 * 136);
  float* sDt = sAc + 128;
  float* sWg = sDt + 128;
  float* sTot = sWg + 128;
  bf16_t* sYst = (bf16_t*)(sTot + 4);
  const bf16_t* XC = (const bf16_t*)(p.ws + WS_XBC);
  const float* DT = (const float*)(p.ws + WS_DT);
  const float LOG2E = 1.4426950408889634f;
  const int lt = (blockIdx.x * 2 >= gridDim.x) ? 3 - wave : wave;
  int nb, j0, xcd;
  if ((gridDim.x & 7) == 0) { xcd = blockIdx.x & 7; j0 = blockIdx.x >> 3; nb = gridDim.x >> 3; }
  else { xcd = 0; j0 = blockIdx.x; nb = gridDim.x; }
  const int per = ((gridDim.x & 7) == 0) ? 192 : 1536;
  for (int idx = j0; idx < per; idx += nb) {
    int item;
    if ((gridDim.x & 7) == 0) item = (idx < 64) ? (xcd * 64 + idx) : (512 + xcd * 128 + (idx - 64));
    else item = idx;
    const bool smp = item < 512;
    const int it = smp ? item : item - 512;
    const int e8 = it & 7, g = (it >> 3) & 3, dir = (it >> 5) & 1, b = it >> 6, h = g * 8 + e8;
    const int L = smp ? 1024 : 256, nc = L >> 7;
    const int tokbase = smp ? (T_P + b * 1024) : (b * 256);
    const float a_neg = -fexp(p.in[26][dir * 32 + h]) * LOG2E;
    const float dsk = p.in[27][h];
    bf16_t* Y = (bf16_t*)(p.ws + (dir ? WS_YB : WS_YF));
    f32x16 accS[2];
    if (smp) {
      const float* st = p.in[4] + ((size_t)(b * 2 + dir) * 32 + h) * 8192;
#pragma unroll
      for (int pt = 0; pt < 2; ++pt)
#pragma unroll
        for (int q4 = 0; q4 < 4; ++q4) {
          const f32x4 v4 = *(const f32x4*)(st + (pt * 32 + l31) * 128 + wave * 32 + 8 * q4 + 4 * hf);
          accS[pt][4 * q4] = v4.x; accS[pt][4 * q4 + 1] = v4.y; accS[pt][4 * q4 + 2] = v4.z; accS[pt][4 * q4 + 3] = v4.w;
        }
    } else {
#pragma unroll
      for (int pt = 0; pt < 2; ++pt)
#pragma unroll
        for (int r = 0; r < 16; ++r) accS[pt][r] = 0.f;
    }
    u32x4 rB[8], rX[4]; float rdt = 0.f; bf16x8 cf[8];
    auto prefetch = [&](int c) {
#pragma unroll
      for (int i = 0; i < 8; ++i) {
        const int ch = tid + 256 * i; const int r = ch >> 4, part = ch & 15;
        const int pos = c * 128 + r; const int tok = tokbase + (dir ? (L - 1 - pos) : pos);
        rB[i] = *(const u32x4*)(XC + (size_t)tok * 3072 + 2048 + g * 128 + part * 8);
      }
#if PF_X
#pragma unroll
      for (int i = 0; i < 4; ++i) {
        const int ch = tid + 256 * i; const int r = ch & 127, part = ch >> 7;
        const int pos = c * 128 + r; const int tok = tokbase + (dir ? (L - 1 - pos) : pos);
        rX[i] = *(const u32x4*)(XC + (size_t)tok * 3072 + h * 64 + part * 8);
      }
#endif
      if (tid < 128) {
        const int pos = c * 128 + tid; const int tok = tokbase + (dir ? (L - 1 - pos) : pos);
        rdt = DT[(size_t)tok * 64 + dir * 32 + h];
      }
    };
    auto load_cf = [&](int c) {
      const int pos = c * 128 + lt * 32 + l31; const int tok = tokbase + (dir ? (L - 1 - pos) : pos);
      const bf16_t* cp = XC + (size_t)tok * 3072 + 2560 + g * 128 + hf * 8;
#pragma unroll
      for (int ks = 0; ks < 8; ++ks) cf[ks] = *(const bf16x8*)(cp + ks * 16);
    };
    prefetch(0);
#if PF_C
    load_cf(0);
#endif
    __syncthreads();
#pragma unroll
    for (int pt = 0; pt < 2; ++pt)
#pragma unroll
      for (int q4 = 0; q4 < 4; ++q4) {
        u32x2 o; o.x = pk2(accS[pt][4 * q4], accS[pt][4 * q4 + 1]); o.y = pk2(accS[pt][4 * q4 + 2], accS[pt][4 * q4 + 3]);
        *(u32x2*)(sS + (pt * 32 + l31) * 136 + wave * 32 + 8 * q4 + 4 * hf) = o;
      }

    for (int c = 0; c < nc; ++c) {
#if !PF_C
      load_cf(c);
#endif
#pragma unroll
      for (int i = 0; i < 8; ++i) { const int ch = tid + 256 * i; const int r = ch >> 4, part = ch & 15; *(u32x4*)(sB + r * 136 + part * 8) = rB[i]; }
#if !PF_X
#pragma unroll
      for (int i = 0; i < 4; ++i) {
        const int ch = tid + 256 * i; const int r = ch & 127, part = ch >> 7;
        const int pos = c * 128 + r; const int tok = tokbase + (dir ? (L - 1 - pos) : pos);
        rX[i] = *(const u32x4*)(XC + (size_t)tok * 3072 + h * 64 + part * 8);
      }
#endif
#pragma unroll
      for (int i = 0; i < 4; ++i) {
        const int ch = tid + 256 * i; const int r = ch & 127, part = ch >> 7;
        const u32x4 v = rX[i];
        bf16_t* d = sXT + (part * 8) * 136 + r;
        d[0] = (bf16_t)(v.x & 0xffff); d[136] = (bf16_t)(v.x >> 16);
        d[2 * 136] = (bf16_t)(v.y & 0xffff); d[3 * 136] = (bf16_t)(v.y >> 16);
        d[4 * 136] = (bf16_t)(v.z & 0xffff); d[5 * 136] = (bf16_t)(v.z >> 16);
        d[6 * 136] = (bf16_t)(v.w & 0xffff); d[7 * 136] = (bf16_t)(v.w >> 16);
      }
      const float dtv = rdt;
      float v = (tid < 128) ? dtv * a_neg : 0.f;
#pragma unroll
      for (int o = 1; o < 64; o <<= 1) { const float t = __shfl_up(v, o); if (lane >= o) v += t; }
      if (lane == 63) sTot[wave] = v;
      __syncthreads();
      if (wave == 1) v += sTot[0];
      if (tid < 128) { sAc[tid] = v; sDt[tid] = dtv; }
      __syncthreads();
      const float a_last = sAc[127];
      if (tid < 128) sWg[tid] = dtv * fexp2(a_last - v);
      const float acl = sAc[lt * 32 + l31];
      const float ea_l = fexp2(acl);
      f32x16 accY[2];
#pragma unroll
      for (int pt = 0; pt < 2; ++pt) {
#pragma unroll
        for (int r = 0; r < 16; ++r) accY[pt][r] = 0.f;
#pragma unroll
        for (int ks = 0; ks < 8; ++ks) {
          const bf16x8 a = *(const bf16x8*)(sS + (pt * 32 + l31) * 136 + ks * 16 + hf * 8);
          accY[pt] = MFMA32(a, cf[ks], accY[pt]);
        }
#pragma unroll
        for (int r = 0; r < 16; ++r) accY[pt][r] *= ea_l;
      }
      float* sw2 = (float*)(sYst + wave * (32 * 40));
      float el = 0.f;
      if (lt > 0) {
        const float a_ref = sAc[lt * 32 - 1];
        el = fexp2(acl - a_ref);
        for (int sidx = lane; sidx < lt * 32; sidx += 64) sw2[sidx] = fexp2(a_ref - sAc[sidx]) * sDt[sidx];
      }
      auto diag_tile = [&](int st, auto diag_tag) {
        constexpr bool DIAG = decltype(diag_tag)::value;
        f32x16 cbT;
#pragma unroll
        for (int r = 0; r < 16; ++r) cbT[r] = 0.f;
#pragma unroll
        for (int ks = 0; ks < 8; ++ks) {
          const bf16x8 a = *(const bf16x8*)(sB + (st * 32 + l31) * 136 + ks * 16 + hf * 8);
          cbT = MFMA32(a, cf[ks], cbT);
        }
        const int lrow = lt * 32 + l31;
        if (!DIAG) {
#pragma unroll
          for (int q4 = 0; q4 < 4; ++q4) {
            const f32x4 w4 = *(const f32x4*)(sw2 + st * 32 + 8 * q4 + 4 * hf);
            cbT[4 * q4 + 0] *= el * w4.x; cbT[4 * q4 + 1] *= el * w4.y; cbT[4 * q4 + 2] *= el * w4.z; cbT[4 * q4 + 3] *= el * w4.w;
          }
        } else {
#pragma unroll 1
          for (int q4h = 0; q4h < 2; ++q4h)
#pragma unroll
          for (int q4 = 2 * q4h; q4 < 2 * q4h + 2; ++q4) {
            const int sbase = st * 32 + 8 * q4 + 4 * hf;
            const f32x4 ac4 = *(const f32x4*)(sAc + sbase);
            const f32x4 dt4 = *(const f32x4*)(sDt + sbase);
            cbT[4 * q4 + 0] = (sbase + 0 <= lrow) ? cbT[4 * q4 + 0] * fexp2(acl - ac4.x) * dt4.x : 0.f;
            cbT[4 * q4 + 1] = (sbase + 1 <= lrow) ? cbT[4 * q4 + 1] * fexp2(acl - ac4.y) * dt4.y : 0.f;
            cbT[4 * q4 + 2] = (sbase + 2 <= lrow) ? cbT[4 * q4 + 2] * fexp2(acl - ac4.z) * dt4.z : 0.f;
            cbT[4 * q4 + 3] = (sbase + 3 <= lrow) ? cbT[4 * q4 + 3] * fexp2(acl - ac4.w) * dt4.w : 0.f;
          }
        }
#pragma unroll
        for (int s2 = 0; s2 < 2; ++s2) {
          u32x4 pw;
          pw.x = pk2(cbT[8 * s2 + 0], cbT[8 * s2 + 1]); pw.y = pk2(cbT[8 * s2 + 2], cbT[8 * s2 + 3]);
          pw.z = pk2(cbT[8 * s2 + 4], cbT[8 * s2 + 5]); pw.w = pk2(cbT[8 * s2 + 6], cbT[8 * s2 + 7]);
          const bf16x8 pf = __builtin_bit_cast(bf16x8, pw);
#pragma unroll
          for (int pt = 0; pt < 2; ++pt) {
            const bf16_t* xp = sXT + (pt * 32 + l31) * 136 + st * 32 + s2 * 16 + hf * 4;
            const u32x2 lo = *(const u32x2*)xp, hi = *(const u32x2*)(xp + 8);
            u32x4 aw; aw.x = lo.x; aw.y = lo.y; aw.z = hi.x; aw.w = hi.y;
            accY[pt] = MFMA32(__builtin_bit_cast(bf16x8, aw), pf, accY[pt]);
          }
        }
      };
      for (int st = 0; st < lt; ++st) diag_tile(st, std::false_type{});
      diag_tile(lt, std::true_type{});
      {
        bf16_t* yst = sYst + wave * (32 * 40);
#pragma unroll
        for (int pt = 0; pt < 2; ++pt) {
#pragma unroll
          for (int q4 = 0; q4 < 4; ++q4) {
            u32x2 o; o.x = pk2(accY[pt][4 * q4], accY[pt][4 * q4 + 1]); o.y = pk2(accY[pt][4 * q4 + 2], accY[pt][4 * q4 + 3]);
            *(u32x2*)(yst + l31 * 40 + 8 * q4 + 4 * hf) = o;
          }
#pragma unroll
          for (int it = 0; it < 2; ++it) {
            const int row = (lane >> 2) + 16 * it, chunk = lane & 3;
            const u32x4 v4 = *(const u32x4*)(yst + row * 40 + chunk * 8);
            const int pos = c * 128 + lt * 32 + row; const int tok = tokbase + (dir ? (L - 1 - pos) : pos);
            u32x4 o4 = v4;
            if (dir == 0) {
              const u32x4 xv = *(const u32x4*)(XC + (size_t)tok * 3072 + h * 64 + pt * 32 + chunk * 8);
              o4.x = pk2(bflo(v4.x) + dsk * bflo(xv.x), bfhi(v4.x) + dsk * bfhi(xv.x));
              o4.y = pk2(bflo(v4.y) + dsk * bflo(xv.y), bfhi(v4.y) + dsk * bfhi(xv.y));
              o4.z = pk2(bflo(v4.z) + dsk * bflo(xv.z), bfhi(v4.z) + dsk * bfhi(xv.z));
              o4.w = pk2(bflo(v4.w) + dsk * bflo(xv.w), bfhi(v4.w) + dsk * bfhi(xv.w));
            }
            *(u32x4*)(Y + (size_t)tok * 2048 + h * 64 + pt * 32 + chunk * 8) = o4;
          }
        }
      }
      __syncthreads();
      if (c + 1 < nc) {
        prefetch(c + 1);
#if PF_C
        load_cf(c + 1);
#endif
      }
      {
        const float dec = fexp2(a_last);
#pragma unroll
        for (int pt = 0; pt < 2; ++pt)
#pragma unroll
          for (int r = 0; r < 16; ++r) accS[pt][r] *= dec;
#pragma unroll 2
        for (int ks = 0; ks < 8; ++ks) {
          const int sb = ks * 16 + hf * 8;
          const f32x4 w0 = *(const f32x4*)(sWg + sb), w1 = *(const f32x4*)(sWg + sb + 4);
          const bf16_t* bp = sB + sb * 136 + wave * 32 + l31;
          u32x4 bw;
          bw.x = pk2(bf2f(bp[0]) * w0.x, bf2f(bp[136]) * w0.y);
          bw.y = pk2(bf2f(bp[2 * 136]) * w0.z, bf2f(bp[3 * 136]) * w0.w);
          bw.z = pk2(bf2f(bp[4 * 136]) * w1.x, bf2f(bp[5 * 136]) * w1.y);
          bw.w = pk2(bf2f(bp[6 * 136]) * w1.z, bf2f(bp[7 * 136]) * w1.w);
          const bf16x8 bfrag = __builtin_bit_cast(bf16x8, bw);
#pragma unroll
          for (int pt = 0; pt < 2; ++pt) {
            const bf16x8 a = *(const bf16x8*)(sXT + (pt * 32 + l31) * 136 + ks * 16 + hf * 8);
            accS[pt] = MFMA32(bfrag, a, accS[pt]);
          }
        }
      }
#pragma unroll
      for (int pt = 0; pt < 2; ++pt)
#pragma unroll
        for (int q4 = 0; q4 < 4; ++q4) {
          u32x2 o; o.x = pk2(accS[pt][4 * q4], accS[pt][4 * q4 + 1]); o.y = pk2(accS[pt][4 * q4 + 2], accS[pt][4 * q4 + 3]);
          *(u32x2*)(sS + (pt * 32 + l31) * 136 + wave * 32 + 8 * q4 + 4 * hf) = o;
        }
      __syncthreads();
    }
    if (!smp) {
      float* o = p.out + OUT_ST + ((size_t)(b * 2 + dir) * 32 + h) * 8192;
#pragma unroll
      for (int pt = 0; pt < 2; ++pt)
#pragma unroll
        for (int q4 = 0; q4 < 4; ++q4) {
          f32x4 v4 = {accS[pt][4 * q4], accS[pt][4 * q4 + 1], accS[pt][4 * q4 + 2], accS[pt][4 * q4 + 3]};
          *(f32x4*)(o + (pt * 32 + l31) * 128 + wave * 32 + 8 * q4 + 4 * hf) = v4;
        }
    }
  }
}

DI void phase_combine(const Params& p) {
  const int tid = threadIdx.x, lane = tid & 63, wave = tid >> 6;
  const bf16_t* YF = (const bf16_t*)(p.ws + WS_YF);
  const bf16_t* YB = (const bf16_t*)(p.ws + WS_YB);
  const bf16_t* XC = (const bf16_t*)(p.ws + WS_XBC);
  bf16_t* Z = (bf16_t*)(p.ws + WS_Z);
  const float* dsk = p.in[27];
  const float* gn = p.in[28];
  for (int row = blockIdx.x * 4 + wave; row < T_ALL; row += gridDim.x * 4) {
    float v[32]; float ss = 0.f;
#pragma unroll
    for (int j = 0; j < 4; ++j) {
      const int c = lane * 8 + 512 * j;
      const u32x4 yf = *(const u32x4*)(YF + (size_t)row * 2048 + c);
      const u32x4 yb = *(const u32x4*)(YB + (size_t)row * 2048 + c);
      const u32x4 z = *(const u32x4*)(Z + (size_t)row * 2048 + c);
      const unsigned yfw[4] = {yf.x, yf.y, yf.z, yf.w}, ybw[4] = {yb.x, yb.y, yb.z, yb.w}, zw[4] = {z.x, z.y, z.z, z.w};
#pragma unroll
      for (int e = 0; e < 4; ++e) {
        const float a = (bflo(yfw[e]) + bflo(ybw[e])) * siluf(bflo(zw[e]));
        const float b = (bfhi(yfw[e]) + bfhi(ybw[e])) * siluf(bfhi(zw[e]));
        v[j * 8 + 2 * e] = a; v[j * 8 + 2 * e + 1] = b; ss += a * a + b * b;
      }
    }
    ss = wave_sum(ss);
    const float rstd = rsqrtf(ss * (1.f / 2048.f) + 1e-6f);
#pragma unroll
    for (int j = 0; j < 4; ++j) {
      const int c = lane * 8 + 512 * j;
      const f32x4 g0 = *(const f32x4*)(gn + c), g1 = *(const f32x4*)(gn + c + 4);
      u32x4 o;
      o.x = pk2(v[j * 8 + 0] * rstd * g0.x, v[j * 8 + 1] * rstd * g0.y);
      o.y = pk2(v[j * 8 + 2] * rstd * g0.z, v[j * 8 + 3] * rstd * g0.w);
      o.z = pk2(v[j * 8 + 4] * rstd * g1.x, v[j * 8 + 5] * rstd * g1.y);
      o.w = pk2(v[j * 8 + 6] * rstd * g1.z, v[j * 8 + 7] * rstd * g1.w);
      *(u32x4*)(Z + (size_t)row * 2048 + c) = o;
    }
  }
}

DI void phase_final(const Params& p) {
  const int tid = threadIdx.x, lane = tid & 63, wave = tid >> 6;
  const float* g = p.in[10];
  const bf16_t* X2 = (const bf16_t*)(p.ws + WS_X2);
  const int nw = gridDim.x * 4;
  for (int row = blockIdx.x * 4 + wave; row < T_ALL; row += 2 * nw) {
    const int row2 = row + nw;
    const bool has2 = row2 < T_ALL;
    const int rb = has2 ? row2 : row;
    u32x4 a[2], b[2];
#pragma unroll
    for (int jj = 0; jj < 2; ++jj) { a[jj] = *(const u32x4*)(X2 + (size_t)row * 1024 + lane * 8 + 512 * jj); b[jj] = *(const u32x4*)(X2 + (size_t)rb * 1024 + lane * 8 + 512 * jj); }
    float va[16], vb[16]; float ss = 0.f, ss2 = 0.f;
#pragma unroll
    for (int jj = 0; jj < 2; ++jj) {
      const unsigned aw[4] = {a[jj].x, a[jj].y, a[jj].z, a[jj].w}, bw[4] = {b[jj].x, b[jj].y, b[jj].z, b[jj].w};
#pragma unroll
      for (int e = 0; e < 4; ++e) {
        va[jj * 8 + 2 * e] = bflo(aw[e]); va[jj * 8 + 2 * e + 1] = bfhi(aw[e]);
        vb[jj * 8 + 2 * e] = bflo(bw[e]); vb[jj * 8 + 2 * e + 1] = bfhi(bw[e]);
      }
    }
#pragma unroll
    for (int i = 0; i < 16; ++i) { ss += va[i] * va[i]; ss2 += vb[i] * vb[i]; }
    ss = wave_sum(ss); ss2 = wave_sum(ss2);
    const float rstd = rsqrtf(ss * (1.f / 1024.f) + 1e-6f), rstd2 = rsqrtf(ss2 * (1.f / 1024.f) + 1e-6f);
    float* yr = p.out + OUT_Y + (size_t)row * 1024;
    float* yr2 = p.out + OUT_Y + (size_t)rb * 1024;
#pragma unroll
    for (int jj = 0; jj < 2; ++jj)
#pragma unroll
      for (int hq = 0; hq < 2; ++hq) {
        const int c = lane * 8 + 512 * jj + 4 * hq;
        const f32x4 gg = *(const f32x4*)(g + c);
        const int i0 = jj * 8 + hq * 4;
        f32x4 o = {va[i0] * rstd * gg.x, va[i0 + 1] * rstd * gg.y, va[i0 + 2] * rstd * gg.z, va[i0 + 3] * rstd * gg.w};
        *(f32x4*)(yr + c) = o;
        if (has2) {
          f32x4 o2 = {vb[i0] * rstd2 * gg.x, vb[i0 + 1] * rstd2 * gg.y, vb[i0 + 2] * rstd2 * gg.z, vb[i0 + 3] * rstd2 * gg.w};
          *(f32x4*)(yr2 + c) = o2;
        }
      }
  }
}

constexpr int N_PHASES = 14;
#ifndef PHASE_ONLY
#define PHASE_ONLY -1
#endif
#define PH_EN(k) (PHASE_ONLY < 0 || PHASE_ONLY == (k))

#ifndef DUP_MASK
#define DUP_MASK 0
#endif
#define RUN_PHASE(k, ...) if (PH_EN(k) && ph_lo <= (k) && (k) < ph_hi) { if ((k) > ph_lo) xcd_barrier(xb); __VA_ARGS__ \
    if ((DUP_MASK >> (k)) & 1) { xcd_barrier(xb); __VA_ARGS__ } }

__global__ void __launch_bounds__(NTHR, 2) mega(Params p, int ph_lo, int ph_hi) {
  extern __shared__ __attribute__((aligned(16))) unsigned char smem[];
  volatile LAS unsigned* xst = (volatile LAS unsigned*)(smem + LDS_BYTES - 16);
  if (threadIdx.x == 0) { xst[0] = 0u; xst[1] = 0u; xst[2] = 0u; xst[3] = 0u; }
  __syncthreads();
  XcdBarrier xb = xcd_barrier_post((unsigned*)(p.ws + WS_BAR), xst);
  if (ph_hi > 1000) cg::this_grid().sync();
  RUN_PHASE(0, phase0(p, smem);)
  RUN_PHASE(1, phase_h(p, 0, p.in[0], p.in[1], nullptr, (bf16_t*)(p.ws + WS_H0), smem);)
  RUN_PHASE(2, {
    EpiAin e{(bf16_t*)(p.ws + WS_UA)};
    gemm_phase<true>((const bf16_t*)(p.ws + WS_H0), 1024, (const bf16_t*)(p.ws + WS_WT_AIN), 1024, 1024, 96, 20, smem, e);
  })
  RUN_PHASE(3, phase3(p, smem);)
  RUN_PHASE(4, {
    EpiQ eq{(bf16_t*)(p.ws + WS_Q), (const float*)(p.ws + WS_ROPE)};
    gemm_phase<true>((const bf16_t*)(p.ws + WS_QN), 256, (const bf16_t*)(p.ws + WS_WT_UQ), 256, 256, 96, 6, smem, eq);
    EpiKV ek{(bf16_t*)(p.ws + WS_KN), (bf16_t*)(p.ws + WS_VTP), (bf16_t*)(p.ws + WS_VTS)};
    gemm_phase<true>((const bf16_t*)(p.ws + WS_CKV), 128, (const bf16_t*)(p.ws + WS_WT_UKV), 128, 128, 128, 8, smem, ek);
  })
  RUN_PHASE(5, phase_attn(p, smem);)
  RUN_PHASE(6, {
    EpiRes e{(const float*)(p.ws + WS_MODP), 0, p.in[0], p.in[1], nullptr, (bf16_t*)(p.out + OUT_Y), nullptr, 0};
    gemm_phase<true>((const bf16_t*)(p.ws + WS_MIX), 1024, (const bf16_t*)(p.ws + WS_WT_AOUT), 1024, 1024, 96, 8, smem, e);
    if ((gridDim.x & 7) == 0 && gridDim.x == 512) { const int j = blockIdx.x >> 3; if (j >= 32) convert_c_weights(p, (j - 32) * 8 + (blockIdx.x & 7), 256, smem); }
    else convert_c_weights(p, blockIdx.x, gridDim.x, smem);
  })
  RUN_PHASE(7, phase_h(p, 1, nullptr, nullptr, (const bf16_t*)(p.out + OUT_Y), (bf16_t*)(p.ws + WS_H1), smem);)
  RUN_PHASE(8, {
    EpiCin e{(bf16_t*)(p.ws + WS_Z), (bf16_t*)(p.ws + WS_XBCR), (float*)(p.ws + WS_DT), p.in[25]};
    gemm_phase<true>((const bf16_t*)(p.ws + WS_H1), 1024, (const bf16_t*)(p.ws + WS_WT_CIN), 1024, 1024, 96, 41, smem, e);
  })
  RUN_PHASE(9, phase_conv5(p);)
  RUN_PHASE(10, phase_scan(p, smem);)
  RUN_PHASE(11, phase_combine(p);)
  RUN_PHASE(12, {
    EpiRes e{(const float*)(p.ws + WS_MODP), 1, nullptr, nullptr, (const bf16_t*)(p.out + OUT_Y), (bf16_t*)(p.ws + WS_X2), nullptr, 0};
    gemm_phase<true, 2>((const bf16_t*)(p.ws + WS_Z), 2048, (const bf16_t*)(p.ws + WS_WT_COUT), 2048, 1024, 96, 8, smem, e);
  })
  RUN_PHASE(13, phase_final(p);)
}

extern "C" void kernel_launch(void* const* d_in, const int* in_sizes, int n_in, void* d_out, int out_size,
                              void* d_ws, size_t ws_size, hipStream_t stream) {
  static int grid_blocks = 0;
  if (grid_blocks == 0) {
    if (n_in != 30 || ws_size < WS_NEED) {
      fprintf(stderr, "kernel_launch: expected 30 inputs and >= %zu B of workspace, got %d / %zu\n", (size_t)WS_NEED, n_in, ws_size);
      grid_blocks = -1; return;
    }
    int dev = 0, cus = 0, per_cu = 0;
    hipGetDevice(&dev);
    hipDeviceGetAttribute(&cus, hipDeviceAttributeMultiprocessorCount, dev);
    if (hipFuncSetAttribute((const void*)mega, hipFuncAttributeMaxDynamicSharedMemorySize, LDS_BYTES) != hipSuccess)
      fprintf(stderr, "kernel_launch: hipFuncSetAttribute failed\n");
    if (hipOccupancyMaxActiveBlocksPerMultiprocessor(&per_cu, (const void*)mega, NTHR, LDS_BYTES) != hipSuccess || per_cu < 1) {
      fprintf(stderr, "kernel_launch: occupancy query failed (%d)\n", per_cu);
      per_cu = 1;
    }
    if (per_cu > 2) per_cu = 2;
    grid_blocks = cus * per_cu;
    (void)hipGetLastError();
  }
  if (grid_blocks < 0) return;
  Params p{};
  for (int i = 0; i < 30; ++i) p.in[i] = (const float*)d_in[i];
  p.out = (float*)d_out;
  p.ws = (unsigned char*)d_ws;
#if ONE_LAUNCH
  if (hipMemsetAsync((unsigned char*)d_ws + WS_BAR, 0, XCD_BAR_WORDS * 4, stream) != hipSuccess) fprintf(stderr, "kernel_launch: memset of barrier words failed\n");
  int lo = 0, hi = N_PHASES;
  void* args[] = {&p, &lo, &hi};
  hipError_t e = hipLaunchCooperativeKernel((const void*)mega, dim3(grid_blocks), dim3(NTHR), args, LDS_BYTES, stream);
  if (e != hipSuccess) fprintf(stderr, "cooperative launch failed: %s (grid %d)\n", hipGetErrorString(e), grid_blocks);
#else
  for (int ph = 0; ph < N_PHASES; ++ph) {
    hipLaunchKernelGGL(mega, dim3(grid_blocks), dim3(NTHR), LDS_BYTES, stream, p, ph, ph + 1);
  }
#endif
}
```

```cpp
#include <hip/hip_runtime.h>
#include <hip/hip_cooperative_groups.h>
#include <cstdio>
#include <cstdint>
#include <type_traits>
namespace cg = cooperative_groups;

#ifndef PF_C
#define PF_C 1
#endif
#ifndef PF_X
#define PF_X 0
#endif
#ifndef ONE_LAUNCH
#define ONE_LAUNCH 1
#endif

typedef unsigned short bf16_t;
typedef __attribute__((ext_vector_type(8))) short bf16x8;
typedef __attribute__((ext_vector_type(4))) short bf16x4;
typedef __attribute__((ext_vector_type(16))) float f32x16;
typedef __attribute__((ext_vector_type(4))) float f32x4;
typedef __attribute__((ext_vector_type(4))) unsigned u32x4;
typedef __attribute__((ext_vector_type(2))) unsigned u32x2;

#define DI __device__ __forceinline__
#define MFMA32(a, b, c) __builtin_amdgcn_mfma_f32_32x32x16_bf16((a), (b), (c), 0, 0, 0)

constexpr int NTHR = 256;
constexpr int LDS_BYTES = 80 * 1024;
constexpr int T_P = 4096, T_ALL = 12288;
constexpr int KVROWS = 16384;

constexpr size_t WS_WT_AIN  = 0;
constexpr size_t WS_WT_UQ   = WS_WT_AIN + 2560ull * 1024 * 2;
constexpr size_t WS_WT_UKV  = WS_WT_UQ + 768ull * 256 * 2;
constexpr size_t WS_WT_AOUT = WS_WT_UKV + 1024ull * 128 * 2;
constexpr size_t WS_WT_CIN  = WS_WT_AOUT + 1024ull * 1024 * 2;
constexpr size_t WS_WT_COUT = WS_WT_CIN + 5248ull * 1024 * 2;
constexpr size_t WS_MODP    = WS_WT_COUT + 1024ull * 2048 * 2;
constexpr size_t WS_ROPE    = WS_MODP + 8ull * 2 * 9 * 3072 * 4;
constexpr size_t WS_BAR     = WS_ROPE + 1024ull * 16 * 2 * 4;
constexpr size_t WS_R       = 24ull * 1024 * 1024;
static_assert(WS_BAR + 16384 <= WS_R, "persistent region overflow");
constexpr size_t WS_H0  = WS_R;
constexpr size_t WS_UA  = WS_H0 + 12288ull * 1024 * 2;
constexpr size_t WS_QN  = WS_UA + 12288ull * 2464 * 2;
constexpr size_t WS_Q   = WS_QN + 12288ull * 256 * 2;
constexpr size_t WS_CKV = WS_Q + 12288ull * 768 * 2;
constexpr size_t WS_KR  = WS_CKV + 16384ull * 128 * 2;
constexpr size_t WS_KN  = WS_KR + 16384ull * 32 * 2;
constexpr size_t WS_VTP = WS_KN + 16384ull * 512 * 2;
constexpr size_t WS_VTS = WS_VTP + 16ull * 8 * 64 * 256 * 2;
constexpr size_t WS_MIX = WS_VTS + 8ull * 8 * 64 * 1536 * 2;
constexpr size_t WS_A_END = WS_MIX + 12288ull * 1024 * 2;
constexpr size_t WS_Z    = WS_R;
constexpr size_t WS_XBCR = WS_Z + 12288ull * 2048 * 2;
constexpr size_t WS_H1   = WS_XBCR + 12288ull * 3072 * 2;
constexpr size_t WS_XBC  = WS_H1 + 12288ull * 1024 * 2;
constexpr size_t WS_DT   = WS_XBC + 12288ull * 3072 * 2;
constexpr size_t WS_C_END = WS_DT + 12288ull * 64 * 4;
constexpr size_t WS_YF   = WS_XBCR;
constexpr size_t WS_YB   = WS_YF + 12288ull * 2048 * 2;
constexpr size_t WS_X2   = WS_YF;
static_assert(WS_YB + 12288ull * 2048 * 2 == WS_XBC, "y alias mismatch");
constexpr size_t WS_NEED = (WS_A_END > WS_C_END ? WS_A_END : WS_C_END);
static_assert(WS_NEED <= 256ull * 1024 * 1024, "workspace too large");

constexpr size_t OUT_Y   = 0;
constexpr size_t OUT_CKV = 12288ull * 1024;
constexpr size_t OUT_KR  = OUT_CKV + 4096ull * 128;
constexpr size_t OUT_ST  = OUT_KR + 4096ull * 32;

struct Params {
  const float* in[30];
  float* out;
  unsigned char* ws;
};

typedef __bf16 hwbf2_t __attribute__((ext_vector_type(2)));
DI bf16_t f2bf(float f) { __bf16 v = (__bf16)f; return __builtin_bit_cast(bf16_t, v); }
DI float bf2f(unsigned h) { return __uint_as_float(h << 16); }
DI unsigned pk2(float a, float b) { hwbf2_t v = {(__bf16)a, (__bf16)b}; return __builtin_bit_cast(unsigned, v); }
DI float bflo(unsigned w) { return __uint_as_float(w << 16); }
DI float bfhi(unsigned w) { return __uint_as_float(w & 0xffff0000u); }
DI float fexp2(float x) { return __builtin_amdgcn_exp2f(x); }
DI float fexp(float x) { return __builtin_amdgcn_exp2f(x * 1.4426950408889634f); }
DI float frcp(float x) { return __builtin_amdgcn_rcpf(x); }
DI float siluf(float x) { return x * frcp(1.f + fexp(-x)); }
DI float sigmoidf_(float x) { return frcp(1.f + fexp(-x)); }
DI int crow(int r, int hf) { return (r & 3) + 8 * (r >> 2) + 4 * hf; }
DI float wave_sum(float v) {
#pragma unroll
  for (int o = 32; o > 0; o >>= 1) v += __shfl_xor(v, o);
  return v;
}
DI int cond_of_row(int row) { return row < T_P ? 0 : 1 + ((row - T_P) >> 10); }
DI float modp_sum(const float* modp, int layer, int cond, int j) {
  float s = 0.f;
#pragma unroll
  for (int kq = 0; kq < 8; ++kq) s += modp[((size_t)((kq * 2 + layer) * 9 + cond)) * 3072 + j];
  return s;
}

#define XB_TMO      128
#define XB_XCNT(j)  (256  + 64 * (j))
#define XB_XSUB(j)  (1280 + 64 * (j))
#define XB_XGEN(j)  (2304 + 64 * (j))
#define XB_TOP      3328
#define XB_TOPGEN   3392
#define XCD_BAR_WORDS 3456
#define XB_SPIN_CAP (1u << 22)
#define LAS __attribute__((address_space(3)))
DI unsigned xb_ld(unsigned* p) { return __hip_atomic_load(p, __ATOMIC_RELAXED, __HIP_MEMORY_SCOPE_AGENT); }
DI unsigned xb_add(unsigned* p, unsigned v) { return __hip_atomic_fetch_add(p, v, __ATOMIC_RELAXED, __HIP_MEMORY_SCOPE_AGENT); }
DI unsigned xb_xcc_id() { return (unsigned)__builtin_amdgcn_s_getreg((3 << 11) | 20) & 0xFu; }
#define XB_SPIN(cond, bar) do { unsigned _sp = 0; while (cond) { __builtin_amdgcn_s_sleep(1); \
    if ((++_sp & 255u) == 0u) { if (xb_ld(&(bar)[XB_TMO])) break; if (_sp > XB_SPIN_CAP) { atomicAdd(&(bar)[XB_TMO], 1u); break; } } } } while (0)
struct XcdBarrier { unsigned* bar; unsigned x; volatile LAS unsigned* st; };
DI XcdBarrier xcd_barrier_post(unsigned* bar, volatile LAS unsigned* st) {
  XcdBarrier b; b.bar = bar; b.x = xb_xcc_id(); b.st = st;
  if (threadIdx.x == 0) (void)xb_add(&bar[XB_XCNT(b.x)], 1u);
  return b;
}
DI void xcd_barrier_complete(unsigned* bar, unsigned x, unsigned& nloc, unsigned& nx) {
  const unsigned G = gridDim.x * gridDim.y * gridDim.z;
  unsigned sum, cnt, mine, sp = 0u;
  for (;;) {
    sum = 0u; cnt = 0u; mine = 0u;
#pragma unroll
    for (unsigned j = 0; j < 16; ++j) { const unsigned c = xb_ld(&bar[XB_XCNT(j)]); sum += c; cnt += (c > 0u) ? 1u : 0u; mine = (j == x) ? c : mine; }
    if (sum == G) break;
    __builtin_amdgcn_s_sleep(1);
    if ((++sp & 255u) == 0u) { if (xb_ld(&bar[XB_TMO])) break; if (sp > XB_SPIN_CAP) { atomicAdd(&bar[XB_TMO], 1u); break; } }
  }
  nloc = mine > 0u ? mine : 1u; nx = cnt > 0u ? cnt : 1u;
}
DI void xcd_barrier(const XcdBarrier& b) {
  asm volatile("s_waitcnt vmcnt(0)" ::: "memory");
  __syncthreads();
  if (threadIdx.x == 0) {
    unsigned* bar = b.bar;
    __builtin_amdgcn_s_waitcnt(0);
    unsigned nloc = b.st[0], nx = b.st[1];
    if (nloc == 0u) { xcd_barrier_complete(bar, b.x, nloc, nx); b.st[0] = nloc; b.st[1] = nx; }
    const unsigned old = xb_add(&bar[XB_XSUB(b.x)], 1u);
    const unsigned gen = old / nloc;
    if (old + 1u == (gen + 1u) * nloc) {
      __builtin_amdgcn_fence(__ATOMIC_RELEASE, "agent");
      asm volatile("s_waitcnt vmcnt(0)" ::: "memory");
      const unsigned og = xb_add(&bar[XB_TOP], 1u);
      const unsigned tg = og / nx;
      if (og + 1u == (tg + 1u) * nx) xb_add(&bar[XB_TOPGEN], 1u);
      else XB_SPIN(xb_ld(&bar[XB_TOPGEN]) == tg, bar);
      __builtin_amdgcn_fence(__ATOMIC_ACQUIRE, "agent");
      xb_add(&bar[XB_XGEN(b.x)], 1u);
      asm volatile("s_waitcnt vmcnt(0)" ::: "memory");
    } else {
      XB_SPIN(xb_ld(&bar[XB_XGEN(b.x)]) == gen, bar);
      __builtin_amdgcn_fence(__ATOMIC_ACQUIRE, "agent");
      asm volatile("s_waitcnt vmcnt(0)" ::: "memory");
    }
  }
  __syncthreads();
}

DI void p0_mod_item(const Params& p, int item, unsigned char* smem) {
  const int kq = item & 7, cc = (item >> 3) % 24, layer = item / 192;
  float* sSil = (float*)smem;
  float* sRed = sSil + 9 * 128;
  const int tid = threadIdx.x;
  __syncthreads();
#pragma unroll
  for (int ii = 0; ii < 5; ++ii) {
    const int i = tid + 256 * ii;
    if (i < 9 * 128) {
      const int cnd = i >> 7, k = i & 127;
      const float v = (cnd == 0) ? p.in[6][kq * 128 + k] : p.in[5][(cnd - 1) * 1024 + kq * 128 + k];
      sSil[i] = siluf(v);
    }
  }
  const int c4 = tid & 31, kg = tid >> 5;
  const float* W = p.in[7] + (size_t)layer * 1024 * 3072 + (size_t)(kq * 128) * 3072 + cc * 128 + c4 * 4;
  f32x4 w[16];
#pragma unroll
  for (int i = 0; i < 16; ++i) w[i] = *(const f32x4*)(W + (size_t)(kg + 8 * i) * 3072);
  __syncthreads();
  float acc[9][4];
#pragma unroll
  for (int c = 0; c < 9; ++c) { acc[c][0] = acc[c][1] = acc[c][2] = acc[c][3] = 0.f; }
#pragma unroll
  for (int i = 0; i < 16; ++i) {
    const int kk = kg + 8 * i;
#pragma unroll
    for (int c = 0; c < 9; ++c) {
      const float s = sSil[c * 128 + kk];
      acc[c][0] += s * w[i].x; acc[c][1] += s * w[i].y; acc[c][2] += s * w[i].z; acc[c][3] += s * w[i].w;
    }
  }
#pragma unroll
  for (int c = 0; c < 9; ++c)
#pragma unroll
    for (int j = 0; j < 4; ++j) sRed[(kg * 9 + c) * 128 + c4 * 4 + j] = acc[c][j];
  __syncthreads();
  float* modp = (float*)(p.ws + WS_MODP);
  for (int i = tid; i < 9 * 128; i += NTHR) {
    int cnd = i >> 7, col = i & 127;
    float s = 0.f;
#pragma unroll
    for (int g = 0; g < 8; ++g) s += sRed[(g * 9 + cnd) * 128 + col];
    if (kq == 0) s += p.in[8][layer * 3072 + cc * 128 + col];
    modp[((size_t)((kq * 2 + layer) * 9 + cnd)) * 3072 + cc * 128 + col] = s;
  }
}

DI void p0_tr_item(const float* W, int K, int N, int ntn, bf16_t* Wt, int tile, unsigned char* smem) {
  float* sT = (float*)smem;
  const int tid = threadIdx.x;
  const int kt = tile / ntn, nt = tile % ntn, k0 = kt * 64, n0 = nt * 64;
  __syncthreads();
#pragma unroll
  for (int i = 0; i < 4; ++i) {
    const int r = (tid >> 4) + 16 * i, c4 = (tid & 15) * 4, n = n0 + c4;
    f32x4 v = {0.f, 0.f, 0.f, 0.f};
    if (n < N) v = *(const f32x4*)(W + (size_t)(k0 + r) * N + n);
    sT[r * 65 + c4 + 0] = v.x; sT[r * 65 + c4 + 1] = v.y; sT[r * 65 + c4 + 2] = v.z; sT[r * 65 + c4 + 3] = v.w;
  }
  __syncthreads();
  const int n = tid >> 2, kc = (tid & 3) * 16;
  u32x4 o0, o1;
  o0.x = pk2(sT[(kc + 0) * 65 + n], sT[(kc + 1) * 65 + n]);   o0.y = pk2(sT[(kc + 2) * 65 + n], sT[(kc + 3) * 65 + n]);
  o0.z = pk2(sT[(kc + 4) * 65 + n], sT[(kc + 5) * 65 + n]);   o0.w = pk2(sT[(kc + 6) * 65 + n], sT[(kc + 7) * 65 + n]);
  o1.x = pk2(sT[(kc + 8) * 65 + n], sT[(kc + 9) * 65 + n]);   o1.y = pk2(sT[(kc + 10) * 65 + n], sT[(kc + 11) * 65 + n]);
  o1.z = pk2(sT[(kc + 12) * 65 + n], sT[(kc + 13) * 65 + n]); o1.w = pk2(sT[(kc + 14) * 65 + n], sT[(kc + 15) * 65 + n]);
  bf16_t* dst = Wt + (size_t)(n0 + n) * K + k0 + kc;
  *(u32x4*)dst = o0;
  *(u32x4*)(dst + 8) = o1;
}

constexpr int P0_MOD = 384, P0_TR = 976, P0_CACHE = 320, P0_ROPE = 16;
constexpr int P0_ITEMS = P0_MOD + P0_TR + P0_CACHE + P0_ROPE;

DI void phase0(const Params& p, unsigned char* smem) {
  const int tid = threadIdx.x;
  for (int it = blockIdx.x; it < P0_ITEMS; it += gridDim.x) {
    int r = it;
    if (r < P0_MOD) { p0_mod_item(p, r, smem); continue; }
    r -= P0_MOD;
    if (r < P0_TR) {
      if (r < 640) { p0_tr_item(p.in[11], 1024, 2464, 40, (bf16_t*)(p.ws + WS_WT_AIN), r, smem); continue; } r -= 640;
      if (r < 48)  { p0_tr_item(p.in[14], 256, 768, 12, (bf16_t*)(p.ws + WS_WT_UQ), r, smem); continue; } r -= 48;
      if (r < 16)  { p0_tr_item(p.in[15], 128, 512, 8, (bf16_t*)(p.ws + WS_WT_UKV), r, smem); continue; } r -= 16;
      if (r < 16)  { p0_tr_item(p.in[16], 128, 512, 8, (bf16_t*)(p.ws + WS_WT_UKV) + 512 * 128, r, smem); continue; } r -= 16;
      if (r < 256) { p0_tr_item(p.in[21], 1024, 1024, 16, (bf16_t*)(p.ws + WS_WT_AOUT), r, smem); continue; } r -= 256;
      continue;
    }
    r -= P0_TR;
    if (r < P0_CACHE) {
      if (r < 256) {
        const int idx = r * 2048 + tid * 8;
        const int b = idx >> 16, rem = idx & 65535;
        const f32x4 v0 = *(const f32x4*)(p.in[2] + idx), v1 = *(const f32x4*)(p.in[2] + idx + 4);
        u32x4 o; o.x = pk2(v0.x, v0.y); o.y = pk2(v0.z, v0.w); o.z = pk2(v1.x, v1.y); o.w = pk2(v1.z, v1.w);
        *(u32x4*)((bf16_t*)(p.ws + WS_CKV) + (size_t)(4096 + b * 1536) * 128 + rem) = o;
      } else {
        const int idx = (r - 256) * 2048 + tid * 8;
        const int b = idx >> 14, rem = idx & 16383;
        const f32x4 v0 = *(const f32x4*)(p.in[3] + idx), v1 = *(const f32x4*)(p.in[3] + idx + 4);
        u32x4 o; o.x = pk2(v0.x, v0.y); o.y = pk2(v0.z, v0.w); o.z = pk2(v1.x, v1.y); o.w = pk2(v1.z, v1.w);
        *(u32x4*)((bf16_t*)(p.ws + WS_KR) + (size_t)(4096 + b * 1536) * 32 + rem) = o;
      }
      continue;
    }
    r -= P0_CACHE;
    {
      float* rope = (float*)(p.ws + WS_ROPE);
#pragma unroll
      for (int e = 0; e < 4; ++e) {
        const int idx = r * 1024 + tid * 4 + e;
        const int pos = idx >> 4, i = idx & 15;
        const float coord = (float)((i < 8) ? (pos >> 6) : (pos & 63));
        const float inv = powf(10000.f, -(float)(i & 7) / 8.f);
        const float ang = coord * inv;
        float sn, cs; sincosf(ang, &sn, &cs);
        rope[idx * 2] = cs; rope[idx * 2 + 1] = sn;
      }
    }
  }
}

DI void convert_c_weights(const Params& p, int w, int nw, unsigned char* smem) {
  for (int r = w; r < 1824; r += nw) {
    if (r < 1312) p0_tr_item(p.in[22], 1024, 5184, 82, (bf16_t*)(p.ws + WS_WT_CIN), r, smem);
    else p0_tr_item(p.in[29], 2048, 1024, 16, (bf16_t*)(p.ws + WS_WT_COUT), r - 1312, smem);
  }
}

DI void phase_h(const Params& p, int layer, const float* xA  , const float* xB  ,
                const bf16_t* xbf  , bf16_t* H, unsigned char* smem) {
  float* sA = (float*)smem;
  float* sB = sA + 1024;
  const int tid = threadIdx.x, lane = tid & 63, wave = tid >> 6;
  const float* modp = (const float*)(p.ws + WS_MODP);
  const float* g = p.in[9] + layer * 1024;
  for (int unit = blockIdx.x; unit < T_ALL / 16; unit += gridDim.x) {
    const int row0 = unit * 16;
    const int cond = cond_of_row(row0);
    __syncthreads();
    {
      const int j = tid * 4;
      f32x4 sh = {0.f, 0.f, 0.f, 0.f}, sc = {0.f, 0.f, 0.f, 0.f};
#pragma unroll
      for (int kq = 0; kq < 8; ++kq) {
        const float* mp = modp + ((size_t)((kq * 2 + layer) * 9 + cond)) * 3072 + j;
        sh += *(const f32x4*)mp;
        sc += *(const f32x4*)(mp + 1024);
      }
      const f32x4 gg = *(const f32x4*)(g + j);
      f32x4 a = {gg.x * (1.f + sc.x), gg.y * (1.f + sc.y), gg.z * (1.f + sc.z), gg.w * (1.f + sc.w)};
      *(f32x4*)(sA + j) = a;
      *(f32x4*)(sB + j) = sh;
    }
    __syncthreads();
#pragma unroll
    for (int i = 0; i < 4; ++i) {
      const int row = row0 + wave * 4 + i;
      f32x4 v[4]; float ss = 0.f;
      if (xbf != nullptr) {
#pragma unroll
        for (int jj = 0; jj < 2; ++jj) {
          const u32x4 xw = *(const u32x4*)(xbf + (size_t)row * 1024 + lane * 8 + 512 * jj);
          v[2 * jj].x = bflo(xw.x); v[2 * jj].y = bfhi(xw.x); v[2 * jj].z = bflo(xw.y); v[2 * jj].w = bfhi(xw.y);
          v[2 * jj + 1].x = bflo(xw.z); v[2 * jj + 1].y = bfhi(xw.z); v[2 * jj + 1].z = bflo(xw.w); v[2 * jj + 1].w = bfhi(xw.w);
        }
      } else {
        const float* xr = (row < T_P) ? (xA + (size_t)row * 1024) : (xB + (size_t)(row - T_P) * 1024);
#pragma unroll
        for (int j = 0; j < 4; ++j) v[j] = *(const f32x4*)(xr + lane * 8 + 512 * (j >> 1) + 4 * (j & 1));
      }
#pragma unroll
      for (int j = 0; j < 4; ++j) ss += v[j].x * v[j].x + v[j].y * v[j].y + v[j].z * v[j].z + v[j].w * v[j].w;
      ss = wave_sum(ss);
      const float rstd = rsqrtf(ss * (1.f / 1024.f) + 1e-6f);
#pragma unroll
      for (int jj = 0; jj < 2; ++jj) {
        const int c = lane * 8 + 512 * jj;
        const f32x4 a0 = *(const f32x4*)(sA + c), b0 = *(const f32x4*)(sB + c), a1 = *(const f32x4*)(sA + c + 4), b1 = *(const f32x4*)(sB + c + 4);
        const f32x4 x0 = v[2 * jj], x1 = v[2 * jj + 1];
        u32x4 o;
        o.x = pk2(x0.x * rstd * a0.x + b0.x, x0.y * rstd * a0.y + b0.y);
        o.y = pk2(x0.z * rstd * a0.z + b0.z, x0.w * rstd * a0.w + b0.w);
        o.z = pk2(x1.x * rstd * a1.x + b1.x, x1.y * rstd * a1.y + b1.y);
        o.w = pk2(x1.z * rstd * a1.z + b1.z, x1.w * rstd * a1.w + b1.w);
        *(u32x4*)(H + (size_t)row * 1024 + c) = o;
      }
    }
  }
}

template <class Epi, int MODE = 0, bool IL = false, int KH = 1>
DI void gemm_tile(const bf16_t* __restrict__ A, int lda, const bf16_t* __restrict__ Bt, int ldb, int K,
                  int m0, int n0, unsigned char* smem, Epi& epi) {
  bf16_t* sA = (bf16_t*)smem;
  bf16_t* sB = sA + 128 * 64;
  const int tid = threadIdx.x, lane = tid & 63, wave = tid >> 6, wm = wave >> 1, wn = wave & 1, l31 = lane & 31, hf = lane >> 5;
  const int lr = tid >> 3, lc = (tid & 7) * 8;
  const bf16_t* ga = A + (size_t)(m0 + lr) * lda + lc;
  const bf16_t* gb = Bt + (size_t)(n0 + lr) * ldb + lc;
  u32x4 ra0[4], rb0[4], ra1[4], rb1[4];
  f32x16 acc[2][2];
#pragma unroll
  for (int i = 0; i < 2; ++i)
#pragma unroll
    for (int j = 0; j < 2; ++j)
#pragma unroll
      for (int r = 0; r < 16; ++r) acc[i][j][r] = 0.f;
  const int nk = K >> 6;
  constexpr int BUFE = 2 * 128 * 64;
  const int wofs = lr * 64 + (((tid & 7) ^ ((lr >> 1) & 7)) << 3);
  const int rsw = (l31 >> 1) & 7;
  const int rofA = (wm * 64 + l31) * 64, rofB = (wn * 64 + l31) * 64;
#define G_LOAD(RA, RB, KT) _Pragma("unroll") for (int i = 0; i < 4; ++i) { RA[i] = *(const u32x4*)(ga + (size_t)(32 * i) * lda + (KT) * 64); RB[i] = *(const u32x4*)(gb + (size_t)(32 * i) * ldb + (KT) * 64); }
#define G_STORE(RA, RB, SLOT) { bf16_t* nA = sA + (SLOT) * BUFE; bf16_t* nB = sB + (SLOT) * BUFE; _Pragma("unroll") for (int i = 0; i < 4; ++i) { *(u32x4*)(nA + wofs + 32 * 64 * i) = RA[i]; *(u32x4*)(nB + wofs + 32 * 64 * i) = RB[i]; } }
#define G_COMPUTE(SLOT) { const bf16_t* cA = sA + (SLOT) * BUFE; const bf16_t* cB = sB + (SLOT) * BUFE; _Pragma("unroll") for (int ks = 0; ks < 4; ++ks) { \
      const int co = (((ks * 2 + hf) ^ rsw) << 3); \
      const bf16x8 a0 = *(const bf16x8*)(cA + rofA + co); \
      const bf16x8 a1 = *(const bf16x8*)(cA + rofA + 32 * 64 + co); \
      const bf16x8 b0 = *(const bf16x8*)(cB + rofB + co); \
      const bf16x8 b1 = *(const bf16x8*)(cB + rofB + 32 * 64 + co); \
      __builtin_amdgcn_s_setprio(1); \
      acc[0][0] = MFMA32(b0, a0, acc[0][0]); acc[0][1] = MFMA32(b1, a0, acc[0][1]); \
      acc[1][0] = MFMA32(b0, a1, acc[1][0]); acc[1][1] = MFMA32(b1, a1, acc[1][1]); \
      __builtin_amdgcn_s_setprio(0); } }
#pragma unroll 1
  for (int kh = 0; kh < KH; ++kh) {
  G_LOAD(ra0, rb0, 0)
  __syncthreads();
  G_STORE(ra0, rb0, 0)
  G_LOAD(ra0, rb0, 1)
  if (nk > 2) G_LOAD(ra1, rb1, 2)
#define G_STEP(CSLOT, SSLOT, RA, RB, DO_STORE, DO_LOAD, LKT) { \
    const bf16_t* cA = sA + (CSLOT) * BUFE; const bf16_t* cB = sB + (CSLOT) * BUFE; \
    bf16_t* nA = sA + (SSLOT) * BUFE; bf16_t* nB = sB + (SSLOT) * BUFE; \
    _Pragma("unroll") for (int ks = 0; ks < 4; ++ks) { \
      const int co = (((ks * 2 + hf) ^ rsw) << 3); \
      const bf16x8 a0 = *(const bf16x8*)(cA + rofA + co); \
      const bf16x8 a1 = *(const bf16x8*)(cA + rofA + 32 * 64 + co); \
      const bf16x8 b0 = *(const bf16x8*)(cB + rofB + co); \
      const bf16x8 b1 = *(const bf16x8*)(cB + rofB + 32 * 64 + co); \
      acc[0][0] = MFMA32(b0, a0, acc[0][0]); \
      if (DO_STORE) *(u32x4*)(nA + wofs + 32 * 64 * ks) = RA[ks]; \
      acc[0][1] = MFMA32(b1, a0, acc[0][1]); \
      if (DO_LOAD) RA[ks] = *(const u32x4*)(ga + (size_t)(32 * ks) * lda + (LKT) * 64); \
      acc[1][0] = MFMA32(b0, a1, acc[1][0]); \
      if (DO_STORE) *(u32x4*)(nB + wofs + 32 * 64 * ks) = RB[ks]; \
      acc[1][1] = MFMA32(b1, a1, acc[1][1]); \
      if (DO_LOAD) RB[ks] = *(const u32x4*)(gb + (size_t)(32 * ks) * ldb + (LKT) * 64); \
    } }
  if (IL) {
  for (int kt = 0; kt < nk; kt += 2) {
    __syncthreads();
    if (kt + 3 < nk) G_STEP(0, 1, ra0, rb0, true, true, kt + 3)
    else G_STEP(0, 1, ra0, rb0, true, false, 0)
    __syncthreads();
    if (kt + 4 < nk) G_STEP(1, 0, ra1, rb1, true, true, kt + 4)
    else if (kt + 2 < nk) G_STEP(1, 0, ra1, rb1, true, false, 0)
    else G_STEP(1, 0, ra1, rb1, false, false, 0)
  }
  } else {
  for (int kt = 0; kt < nk; kt += 2) {
    __syncthreads();
    G_STORE(ra0, rb0, 1)
    if (kt + 3 < nk) G_LOAD(ra0, rb0, kt + 3)
    G_COMPUTE(0)
    __syncthreads();
    if (kt + 2 < nk) {
      G_STORE(ra1, rb1, 0)
      if (kt + 4 < nk) G_LOAD(ra1, rb1, kt + 4)
    }
    G_COMPUTE(1)
  }
  }
  ga += K; gb += K;
  }
#undef G_STEP
#undef G_LOAD
#undef G_STORE
#undef G_COMPUTE
  __syncthreads();
  float* sT = (float*)smem + wave * (64 * 68);
#pragma unroll
  for (int i = 0; i < 2; ++i)
#pragma unroll
    for (int j = 0; j < 2; ++j)
#pragma unroll
      for (int q = 0; q < 4; ++q) {
        f32x4 v = {acc[i][j][4 * q], acc[i][j][4 * q + 1], acc[i][j][4 * q + 2], acc[i][j][4 * q + 3]};
        *(f32x4*)(sT + (i * 32 + l31) * 68 + j * 32 + 8 * q + 4 * hf) = v;
      }
  epi.wave_tile(sT, m0 + wm * 64, n0 + wn * 64, lane);
}

template <int NIT = 16, class F>
DI void tile_rowwise(const float* sT, int lane, F f) {
#pragma unroll 2
  for (int it = 0; it < NIT; ++it) {
    const int row = (lane >> 4) + 4 * it, col = (lane & 15) * 4;
    const f32x4 v = *(const f32x4*)(sT + row * 68 + col);
    f(row, col, v);
  }
}

template <int NIT = 16, class F>
DI void tile_rowwise8(const float* sT, int lane, F f) {
#pragma unroll 2
  for (int it = 0; it < NIT / 2; ++it) {
    const int row = (lane >> 3) + 8 * it, col = (lane & 7) * 8;
    const f32x4 v0 = *(const f32x4*)(sT + row * 68 + col), v1 = *(const f32x4*)(sT + row * 68 + col + 4);
    u32x4 o; o.x = pk2(v0.x, v0.y); o.y = pk2(v0.z, v0.w); o.z = pk2(v1.x, v1.y); o.w = pk2(v1.z, v1.w);
    f(row, col, o);
  }
}

template <int NIT = 16, class F>
DI void tile_rowwise8f(const float* sT, int lane, F f) {
#pragma unroll 2
  for (int it = 0; it < NIT / 2; ++it) {
    const int row = (lane >> 3) + 8 * it, col = (lane & 7) * 8;
    const f32x4 v0 = *(const f32x4*)(sT + row * 68 + col), v1 = *(const f32x4*)(sT + row * 68 + col + 4);
    f(row, col, v0, v1);
  }
}

struct EpiAin {
  bf16_t* UA;
  DI void prep(int, int, unsigned char*) {}
  template <int NIT = 16>
  DI void wave_tile(const float* sT, int mr, int nc, int lane) {
    bf16_t* ua = UA;
    tile_rowwise8<NIT>(sT, lane, [=](int row, int col, u32x4 o) {
      if (nc + col < 2464) *(u32x4*)(ua + (size_t)(mr + row) * 2464 + nc + col) = o;
    });
  }
};
struct EpiQ {
  DI void after_tile(int, unsigned char*) {}
  bf16_t* Q; const float* rope;
  DI void prep(int, int, unsigned char*) {}
  DI void wave_tile(const float* sT, int mr, int nc, int lane) {
    bf16_t* q = Q; const float* rp = rope;
    tile_rowwise8f(sT, lane, [=](int row, int col, f32x4 v, f32x4 w) {
      const int grow = mr + row, gcol = nc + col;
      const int c96 = gcol % 96;
      if (grow >= T_P && c96 >= 64) {
        const int pos = (grow - T_P) & 1023, ip = (c96 - 64) >> 1;
        const f32x4 cs = *(const f32x4*)(rp + (pos * 16 + ip) * 2);
        const f32x4 cs2 = *(const f32x4*)(rp + (pos * 16 + ip + 2) * 2);
        const float a0 = v.x * cs.x - v.y * cs.y, b0 = v.x * cs.y + v.y * cs.x;
        const float a1 = v.z * cs.z - v.w * cs.w, b1 = v.z * cs.w + v.w * cs.z;
        const float a2 = w.x * cs2.x - w.y * cs2.y, b2 = w.x * cs2.y + w.y * cs2.x;
        const float a3 = w.z * cs2.z - w.w * cs2.w, b3 = w.z * cs2.w + w.w * cs2.z;
        v.x = a0; v.y = b0; v.z = a1; v.w = b1; w.x = a2; w.y = b2; w.z = a3; w.w = b3;
      }
      u32x4 o; o.x = pk2(v.x, v.y); o.y = pk2(v.z, v.w); o.z = pk2(w.x, w.y); o.w = pk2(w.z, w.w);
      *(u32x4*)(q + (size_t)grow * 768 + gcol) = o;
    });
  }
};
struct EpiKV {
  DI void after_tile(int, unsigned char*) {}
  bf16_t* KN; bf16_t* VTP; bf16_t* VTS;
  DI void prep(int, int, unsigned char*) {}
  DI void wave_tile(const float* sT, int mr, int nc, int lane) {
    if (nc < 512) {
      bf16_t* kn = KN;
      tile_rowwise8(sT, lane, [=](int row, int col, u32x4 o) {
        *(u32x4*)(kn + (size_t)(mr + row) * 512 + nc + col) = o;
      });
    } else {
      const int hh = (nc - 512) >> 6;
      bf16_t* base; int Lk, key0;
      if (mr < T_P) { const int b = mr >> 8; key0 = mr & 255; Lk = 256; base = VTP + (size_t)(b * 8 + hh) * 64 * 256; }
      else { const int r2 = mr - T_P, b = r2 / 1536; key0 = r2 - b * 1536; Lk = 1536; base = VTS + (size_t)(b * 8 + hh) * 64 * 1536; }
#pragma unroll 2
      for (int it = 0; it < 8; ++it) {
        const int d = (lane >> 3) + 8 * it, k8 = (lane & 7) * 8;
        const float* sp = sT + k8 * 68 + d;
        u32x4 o;
        o.x = pk2(sp[0], sp[68]); o.y = pk2(sp[2 * 68], sp[3 * 68]); o.z = pk2(sp[4 * 68], sp[5 * 68]); o.w = pk2(sp[6 * 68], sp[7 * 68]);
        *(u32x4*)(base + (size_t)d * Lk + key0 + k8) = o;
      }
    }
  }
};
struct EpiRes {
  const float* modp; int layer; const float* xA; const float* xB; const bf16_t* xin; bf16_t* outb; float* sGate; int gate_n0;
  DI void prep(int m0, int n0, unsigned char* smem) {
    sGate = (float*)(smem + 2 * 36864);
    const int cond = cond_of_row(m0);
    __syncthreads();
    if (threadIdx.x < 128) sGate[threadIdx.x] = modp_sum(modp, layer, cond, 2048 + n0 + threadIdx.x);
    gate_n0 = n0;
  }
  template <int NIT = 16>
  DI void wave_tile(const float* sT, int mr, int nc, int lane) {
    const float* xa = xA; const float* xb = xB; const bf16_t* xi = xin; bf16_t* o = outb; const float* sg = sGate + (nc - gate_n0);
    tile_rowwise8f<NIT>(sT, lane, [=](int row, int col, f32x4 v, f32x4 w) {
      const int grow = mr + row, gcol = nc + col;
      const f32x4 g0 = *(const f32x4*)(sg + col), g1 = *(const f32x4*)(sg + col + 4);
      f32x4 x0, x1;
      if (xi != nullptr) {
        const u32x4 xw = *(const u32x4*)(xi + (size_t)grow * 1024 + gcol);
        x0.x = bflo(xw.x); x0.y = bfhi(xw.x); x0.z = bflo(xw.y); x0.w = bfhi(xw.y);
        x1.x = bflo(xw.z); x1.y = bfhi(xw.z); x1.z = bflo(xw.w); x1.w = bfhi(xw.w);
      } else {
        const float* xp = (grow < T_P) ? (xa + (size_t)grow * 1024 + gcol) : (xb + (size_t)(grow - T_P) * 1024 + gcol);
        x0 = *(const f32x4*)xp; x1 = *(const f32x4*)(xp + 4);
      }
      u32x4 r;
      r.x = pk2(x0.x + g0.x * v.x, x0.y + g0.y * v.y); r.y = pk2(x0.z + g0.z * v.z, x0.w + g0.w * v.w);
      r.z = pk2(x1.x + g1.x * w.x, x1.y + g1.y * w.y); r.w = pk2(x1.z + g1.z * w.z, x1.w + g1.w * w.w);
      *(u32x4*)(o + (size_t)grow * 1024 + gcol) = r;
    });
  }
};
struct EpiCin {
  bf16_t* Z; bf16_t* RAWB; bf16_t* XC; float* DT; const float* dtb; const float* cw; const float* cb;
  DI void prep(int, int, unsigned char*) {}
  template <int NIT = 16>
  DI void wave_tile(const float* sT, int mr, int nc, int lane) {
    if (nc < 2048) {
      bf16_t* z = Z;
      tile_rowwise8<NIT>(sT, lane, [=](int row, int col, u32x4 o) {
        *(u32x4*)(z + (size_t)(mr + row) * 2048 + nc + col) = o;
      });
    } else if (nc < 5120) {
      const int cbase = nc - 2048, col = (lane & 7) * 8, rg = lane >> 3;
      float w[5][8], bias[8];
#pragma unroll
      for (int k = 0; k < 5; ++k) {
        const f32x4 a = *(const f32x4*)(cw + k * 3072 + cbase + col), b4 = *(const f32x4*)(cw + k * 3072 + cbase + col + 4);
        w[k][0] = a.x; w[k][1] = a.y; w[k][2] = a.z; w[k][3] = a.w; w[k][4] = b4.x; w[k][5] = b4.y; w[k][6] = b4.z; w[k][7] = b4.w;
      }
      {
        const f32x4 a = *(const f32x4*)(cb + cbase + col), b4 = *(const f32x4*)(cb + cbase + col + 4);
        bias[0] = a.x; bias[1] = a.y; bias[2] = a.z; bias[3] = a.w; bias[4] = b4.x; bias[5] = b4.y; bias[6] = b4.z; bias[7] = b4.w;
      }
      f32x4 win0[5], win1[5];
#pragma unroll
      for (int j = 0; j < 12; ++j) {
        const int r = rg * 8 - 2 + j;
        f32x4 v0 = {0.f, 0.f, 0.f, 0.f}, v1 = {0.f, 0.f, 0.f, 0.f};
        if (r >= 0 && r < 64) { v0 = *(const f32x4*)(sT + r * 68 + col); v1 = *(const f32x4*)(sT + r * 68 + col + 4); }
        win0[j % 5] = v0; win1[j % 5] = v1;
        if (j >= 2 && j < 10 && (r < 4 || r >= 60)) {
          const int rb = (r < 4) ? r : r - 56;
          u32x4 o; o.x = pk2(v0.x, v0.y); o.y = pk2(v0.z, v0.w); o.z = pk2(v1.x, v1.y); o.w = pk2(v1.z, v1.w);
          *(u32x4*)(RAWB + ((size_t)((mr >> 6) * 8 + rb)) * 3072 + cbase + col) = o;
        }
        if (j >= 4) {
          const int t = j - 4, ro = rg * 8 + t;
          if (ro >= 2 && ro <= 61) {
            float a[8];
#pragma unroll
            for (int e = 0; e < 8; ++e) a[e] = bias[e];
#pragma unroll
            for (int k = 0; k < 5; ++k) {
              const f32x4 x0 = win0[(t + k) % 5], x1 = win1[(t + k) % 5];
              a[0] += x0.x * w[k][0]; a[1] += x0.y * w[k][1]; a[2] += x0.z * w[k][2]; a[3] += x0.w * w[k][3];
              a[4] += x1.x * w[k][4]; a[5] += x1.y * w[k][5]; a[6] += x1.z * w[k][6]; a[7] += x1.w * w[k][7];
            }
            u32x4 o;
            o.x = pk2(siluf(a[0]), siluf(a[1])); o.y = pk2(siluf(a[2]), siluf(a[3]));
            o.z = pk2(siluf(a[4]), siluf(a[5])); o.w = pk2(siluf(a[6]), siluf(a[7]));
            *(u32x4*)(XC + (size_t)(mr + ro) * 3072 + cbase + col) = o;
          }
        }
      }
    } else if (nc < 5184) {
      float* dt = DT; const float* b = dtb;
      tile_rowwise<NIT>(sT, lane, [=](int row, int col, f32x4 v) {
        const int c = nc - 5120 + col;
        const f32x4 bias = *(const f32x4*)(b + c);
        f32x4 r;
        { const float x = v.x + bias.x; r.x = fmaxf(x, 0.f) + log1pf(__expf(-fabsf(x))); }
        { const float x = v.y + bias.y; r.y = fmaxf(x, 0.f) + log1pf(__expf(-fabsf(x))); }
        { const float x = v.z + bias.z; r.z = fmaxf(x, 0.f) + log1pf(__expf(-fabsf(x))); }
        { const float x = v.w + bias.w; r.w = fmaxf(x, 0.f) + log1pf(__expf(-fabsf(x))); }
        *(f32x4*)(dt + (size_t)(mr + row) * 64 + c) = r;
      });
    }
  }
};

template <bool IL = false, int KH = 1, class Epi>
DI void gemm_phase(const bf16_t* A, int lda, const bf16_t* Bt, int ldb, int K, int mtiles, int ntiles, unsigned char* smem, Epi& epi) {
  if ((gridDim.x & 7) == 0 && (mtiles & 7) == 0) {
    const int xcd = blockIdx.x & 7, j = blockIdx.x >> 3, nb = gridDim.x >> 3, mper = mtiles >> 3;
    for (int idx = j; idx < mper * ntiles; idx += nb) {
      const int nt = idx / mper, mt = xcd * mper + (idx - nt * mper);
      epi.prep(mt * 128, nt * 128, smem);
      gemm_tile<Epi, 0, IL, KH>(A, lda, Bt, ldb, K, mt * 128, nt * 128, smem, epi);
    }
  } else {
    for (int t = blockIdx.x; t < mtiles * ntiles; t += gridDim.x) {
      const int mt = t / ntiles, nt = t - mt * ntiles;
      epi.prep(mt * 128, nt * 128, smem);
      gemm_tile<Epi, 0, IL, KH>(A, lda, Bt, ldb, K, mt * 128, nt * 128, smem, epi);
    }
  }
}

template <class Epi>
DI void gemm_tile_big(const bf16_t* __restrict__ A, int lda, const bf16_t* __restrict__ Bt, int ldb, int K,
                      int m0, int n0, unsigned char* smem, Epi& epi) {
  bf16_t* sA = (bf16_t*)smem;
  bf16_t* sB = sA + 256 * 32;
  constexpr int BUFE = 384 * 32;
  const int tid = threadIdx.x, lane = tid & 63, wave = tid >> 6, wm = wave >> 1, wn = wave & 1, l31 = lane & 31, hf = lane >> 5;
  const int lr = tid >> 2, lch = tid & 3;
  const bf16_t* ga = A + (size_t)(m0 + lr) * lda + lch * 8;
  const bf16_t* gb = Bt + (size_t)(n0 + lr) * ldb + lch * 8;
  const int wofs = lr * 32 + ((lch ^ ((lr >> 2) & 3)) << 3);
  const int rsw = (l31 >> 2) & 3;
  const int rofA = (wm * 128 + l31) * 32, rofB = (wn * 64 + l31) * 32;
  u32x4 ra0[4], rb0[2], ra1[4], rb1[2];
  f32x16 acc[4][2];
#pragma unroll
  for (int i = 0; i < 4; ++i)
#pragma unroll
    for (int j = 0; j < 2; ++j)
#pragma unroll
      for (int r = 0; r < 16; ++r) acc[i][j][r] = 0.f;
  const int nk = K >> 5;
#define GB_LOAD(RA, RB, KT) { _Pragma("unroll") for (int i = 0; i < 4; ++i) RA[i] = *(const u32x4*)(ga + (size_t)(64 * i) * lda + (KT) * 32); \
                              _Pragma("unroll") for (int i = 0; i < 2; ++i) RB[i] = *(const u32x4*)(gb + (size_t)(64 * i) * ldb + (KT) * 32); }
#define GB_STORE(RA, RB, SLOT) { bf16_t* nA = sA + (SLOT) * BUFE; bf16_t* nB = sB + (SLOT) * BUFE; \
                              _Pragma("unroll") for (int i = 0; i < 4; ++i) *(u32x4*)(nA + wofs + 64 * 32 * i) = RA[i]; \
                              _Pragma("unroll") for (int i = 0; i < 2; ++i) *(u32x4*)(nB + wofs + 64 * 32 * i) = RB[i]; }
#define GB_COMPUTE(SLOT) { const bf16_t* cA = sA + (SLOT) * BUFE; const bf16_t* cB = sB + (SLOT) * BUFE; _Pragma("unroll") for (int ks = 0; ks < 2; ++ks) { \
      const int co = (((ks * 2 + hf) ^ rsw) << 3); \
      bf16x8 af[4], bfr[2]; \
      _Pragma("unroll") for (int i = 0; i < 4; ++i) af[i] = *(const bf16x8*)(cA + rofA + 32 * 32 * i + co); \
      _Pragma("unroll") for (int j = 0; j < 2; ++j) bfr[j] = *(const bf16x8*)(cB + rofB + 32 * 32 * j + co); \
      __builtin_amdgcn_s_setprio(1); \
      _Pragma("unroll") for (int i = 0; i < 4; ++i) { acc[i][0] = MFMA32(bfr[0], af[i], acc[i][0]); acc[i][1] = MFMA32(bfr[1], af[i], acc[i][1]); } \
      __builtin_amdgcn_s_setprio(0); } }
  GB_LOAD(ra0, rb0, 0)
  __syncthreads();
  GB_STORE(ra0, rb0, 0)
  GB_LOAD(ra0, rb0, 1)
  if (nk > 2) GB_LOAD(ra1, rb1, 2)
  for (int kt = 0; kt < nk; kt += 2) {
    __syncthreads();
    GB_STORE(ra0, rb0, 1)
    if (kt + 3 < nk) GB_LOAD(ra0, rb0, kt + 3)
    GB_COMPUTE(0)
    __syncthreads();
    if (kt + 2 < nk) {
      GB_STORE(ra1, rb1, 0)
      if (kt + 4 < nk) GB_LOAD(ra1, rb1, kt + 4)
    }
    GB_COMPUTE(1)
  }
#undef GB_LOAD
#undef GB_STORE
#undef GB_COMPUTE
  __syncthreads();
  float* sT = (float*)smem + wave * (32 * 68);
#pragma unroll
  for (int i = 0; i < 4; ++i) {
#pragma unroll
    for (int j = 0; j < 2; ++j)
#pragma unroll
      for (int q = 0; q < 4; ++q) {
        f32x4 v = {acc[i][j][4 * q], acc[i][j][4 * q + 1], acc[i][j][4 * q + 2], acc[i][j][4 * q + 3]};
        *(f32x4*)(sT + l31 * 68 + j * 32 + 8 * q + 4 * hf) = v;
      }
    epi.template wave_tile<8>(sT, m0 + wm * 128 + i * 32, n0 + wn * 64, lane);
  }
}

template <class Epi>
DI void gemm_phase_big(const bf16_t* A, int lda, const bf16_t* Bt, int ldb, int K, int mtiles, int ntiles, unsigned char* smem, Epi& epi) {
  if ((gridDim.x & 7) == 0 && (mtiles & 7) == 0) {
    const int xcd = blockIdx.x & 7, j = blockIdx.x >> 3, nb = gridDim.x >> 3, mper = mtiles >> 3;
    for (int idx = j; idx < mper * ntiles; idx += nb) {
      const int nt = idx / mper, mt = xcd * mper + (idx - nt * mper);
      epi.prep(mt * 256, nt * 128, smem);
      gemm_tile_big(A, lda, Bt, ldb, K, mt * 256, nt * 128, smem, epi);
    }
  } else {
    for (int t = blockIdx.x; t < mtiles * ntiles; t += gridDim.x) {
      const int mt = t / ntiles, nt = t - mt * ntiles;
      epi.prep(mt * 256, nt * 128, smem);
      gemm_tile_big(A, lda, Bt, ldb, K, mt * 256, nt * 128, smem, epi);
    }
  }
}

DI float reduce16(const float (&v)[16], int lane) {
  const bool b5 = (lane & 32) != 0, b4 = (lane & 16) != 0, b3 = (lane & 8) != 0, b2 = (lane & 4) != 0;
  float a[8], b[4], c[2];
#pragma unroll
  for (int i = 0; i < 8; ++i) { const float send = b5 ? v[i] : v[i + 8], keep = b5 ? v[i + 8] : v[i]; a[i] = keep + __shfl_xor(send, 32); }
#pragma unroll
  for (int i = 0; i < 4; ++i) { const float send = b4 ? a[i] : a[i + 4], keep = b4 ? a[i + 4] : a[i]; b[i] = keep + __shfl_xor(send, 16); }
#pragma unroll
  for (int i = 0; i < 2; ++i) { const float send = b3 ? b[i] : b[i + 2], keep = b3 ? b[i + 2] : b[i]; c[i] = keep + __shfl_xor(send, 8); }
  const float send = b2 ? c[0] : c[1], keep = b2 ? c[1] : c[0];
  float d = keep + __shfl_xor(send, 4);
  d += __shfl_xor(d, 2);
  d += __shfl_xor(d, 1);
  return d;
}

DI void phase3(const Params& p, unsigned char* smem) {
  const int tid = threadIdx.x, lane = tid & 63, wave = tid >> 6;
  const bf16_t* UA = (const bf16_t*)(p.ws + WS_UA);
  bf16_t* QN = (bf16_t*)(p.ws + WS_QN);
  bf16_t* CKV = (bf16_t*)(p.ws + WS_CKV);
  bf16_t* KR = (bf16_t*)(p.ws + WS_KR);
  bf16_t* MIX = (bf16_t*)(p.ws + WS_MIX);
  const float* rope = (const float*)(p.ws + WS_ROPE);
  const float* gq = p.in[12];
  const float* gkv = p.in[13];
  auto proc = [&](int row, u32x2 wq, unsigned wkv, unsigned wkr) {
    {
      const float a = bflo(wq.x), b = bfhi(wq.x), c = bflo(wq.y), d = bfhi(wq.y);
      const float ss = wave_sum(a * a + b * b + c * c + d * d);
      const float rstd = rsqrtf(ss * (1.f / 256.f) + 1e-6f);
      const f32x4 g = *(const f32x4*)(gq + lane * 4);
      u32x2 o; o.x = pk2(a * rstd * g.x, b * rstd * g.y); o.y = pk2(c * rstd * g.z, d * rstd * g.w);
      *(u32x2*)(QN + (size_t)row * 256 + lane * 4) = o;
    }
    int kvrow; int pos = 0;
    if (row < T_P) kvrow = row;
    else { const int r2 = row - T_P; const int b = r2 >> 10; pos = r2 & 1023; kvrow = T_P + b * 1536 + 512 + pos; }
    {
      const float a = bflo(wkv), b = bfhi(wkv);
      const float ss = wave_sum(a * a + b * b);
      const float rstd = rsqrtf(ss * (1.f / 128.f) + 1e-6f);
      const float oa = a * rstd * gkv[lane * 2], ob = b * rstd * gkv[lane * 2 + 1];
      *(unsigned*)(CKV + (size_t)kvrow * 128 + lane * 2) = pk2(oa, ob);
      if (row < T_P) { float* o = p.out + OUT_CKV + (size_t)row * 128 + lane * 2; o[0] = oa; o[1] = ob; }
    }
    if (lane < 16) {
      float a = bflo(wkr), b = bfhi(wkr);
      if (row < T_P) {
        float* o = p.out + OUT_KR + (size_t)row * 32 + lane * 2; o[0] = a; o[1] = b;
      } else {
        const float cs = rope[(pos * 16 + lane) * 2], sn = rope[(pos * 16 + lane) * 2 + 1];
        const float na = a * cs - b * sn, nb = a * sn + b * cs;
        a = na; b = nb;
      }
      *(unsigned*)(KR + (size_t)kvrow * 32 + lane * 2) = pk2(a, b);
    }
  };
  {
    int rbeg = 0, rend = T_ALL, nw = gridDim.x * 4, w0 = blockIdx.x * 4 + wave;
    if (gridDim.x == 512) {
      if (blockIdx.x >= 384) { rbeg = 0; rend = 6400; nw = 128 * 4; w0 = (blockIdx.x - 384) * 4 + wave; }
      else { rbeg = 6400; rend = T_ALL; nw = 384 * 4; }
    }
    for (int row = rbeg + w0; row < rend; row += 2 * nw) {
      const int row2 = row + nw; const bool has2 = row2 < rend;
      const bf16_t* u0 = UA + (size_t)row * 2464;
      const bf16_t* u1 = UA + (size_t)(has2 ? row2 : row) * 2464;
      const u32x2 wq0 = *(const u32x2*)(u0 + lane * 4), wq1 = *(const u32x2*)(u1 + lane * 4);
      const unsigned wkv0 = *(const unsigned*)(u0 + 256 + lane * 2), wkv1 = *(const unsigned*)(u1 + 256 + lane * 2);
      const unsigned wkr0 = *(const unsigned*)(u0 + 384 + (lane & 15) * 2), wkr1 = *(const unsigned*)(u1 + 384 + (lane & 15) * 2);
      proc(row, wq0, wkv0, wkr0);
      if (has2) proc(row2, wq1, wkv1, wkr1);
    }
  }
  bf16_t* sCv = (bf16_t*)smem;
  float* sRed = (float*)(smem + 62 * 512 * 2);
  const float* cw = p.in[17];
  const float* cb = p.in[18];
  const float* lg = p.in[19];
  const float* lb = p.in[20];
  for (int tile = blockIdx.x; tile < T_ALL / 32; tile += gridDim.x) {
    const int t0 = tile * 32;
    int s0, s1;
    if (t0 < T_P) { s0 = t0 & ~255; s1 = s0 + 256; } else { s0 = T_P + ((t0 - T_P) & ~1023); s1 = s0 + 1024; }
    __syncthreads();
#pragma unroll 8
    for (int ch = tid; ch < 62 * 64; ch += NTHR) {
      const int r = ch >> 6, c8 = (ch & 63) * 8;
      const int row = t0 - 15 + r;
      u32x4 o = {0u, 0u, 0u, 0u};
      if (row >= s0 && row < s1) {
        const u32x4 ga = *(const u32x4*)(UA + (size_t)row * 2464 + 416 + c8);
        const u32x4 gb = *(const u32x4*)(UA + (size_t)row * 2464 + 928 + c8);
        o.x = pk2(bflo(ga.x) * sigmoidf_(bflo(gb.x)), bfhi(ga.x) * sigmoidf_(bfhi(gb.x)));
        o.y = pk2(bflo(ga.y) * sigmoidf_(bflo(gb.y)), bfhi(ga.y) * sigmoidf_(bfhi(gb.y)));
        o.z = pk2(bflo(ga.z) * sigmoidf_(bflo(gb.z)), bfhi(ga.z) * sigmoidf_(bfhi(gb.z)));
        o.w = pk2(bflo(ga.w) * sigmoidf_(bflo(gb.w)), bfhi(ga.w) * sigmoidf_(bfhi(gb.w)));
      }
      *(u32x4*)(sCv + r * 512 + c8) = o;
    }
    __syncthreads();
    const int c = tid * 2;
    float wk0[31], wk1[31];
#pragma unroll
    for (int k = 0; k < 31; ++k) { const float2 w = *(const float2*)(cw + k * 512 + c); wk0[k] = w.x; wk1[k] = w.y; }
#pragma unroll 1
    for (int half = 0; half < 2; ++half) {
      const int tb = half * 16;
      float acc0[16], acc1[16];
      {
        const float b0 = cb[c], b1 = cb[c + 1];
#pragma unroll
        for (int t = 0; t < 16; ++t) { acc0[t] = b0; acc1[t] = b1; }
      }
#pragma unroll
      for (int rho = 0; rho < 46; ++rho) {
        const unsigned w = *(const unsigned*)(sCv + (tb + rho) * 512 + c);
        const float x0 = bflo(w), x1 = bfhi(w);
#pragma unroll
        for (int t = 0; t < 16; ++t) {
          const int k = rho - t;
          if (k >= 0 && k < 31) { acc0[t] += x0 * wk0[k]; acc1[t] += x1 * wk1[k]; }
        }
      }
      __syncthreads();
      const int tsel = ((lane >> 5) & 1) * 8 + ((lane >> 4) & 1) * 4 + ((lane >> 3) & 1) * 2 + ((lane >> 2) & 1);
      {
        float v[16];
#pragma unroll
        for (int t = 0; t < 16; ++t) v[t] = acc0[t] + acc1[t];
        const float tot = reduce16(v, lane);
        if ((lane & 3) == 0) sRed[tsel * 4 + wave] = tot;
      }
      __syncthreads();
      {
        float v[16];
#pragma unroll
        for (int t = 0; t < 16; ++t) {
          const float mean = (sRed[t * 4] + sRed[t * 4 + 1] + sRed[t * 4 + 2] + sRed[t * 4 + 3]) * (1.f / 512.f);
          acc0[t] -= mean; acc1[t] -= mean;
          v[t] = acc0[t] * acc0[t] + acc1[t] * acc1[t];
        }
        const float tot = reduce16(v, lane);
        if ((lane & 3) == 0) sRed[128 + tsel * 4 + wave] = tot;
      }
      __syncthreads();
      {
        const float g0 = lg[c], g1 = lg[c + 1], bb0 = lb[c], bb1 = lb[c + 1];
        __syncthreads();
#pragma unroll
        for (int t = 0; t < 16; ++t) {
          const float var = (sRed[128 + t * 4] + sRed[128 + t * 4 + 1] + sRed[128 + t * 4 + 2] + sRed[128 + t * 4 + 3]) * (1.f / 512.f);
          const float rstd = rsqrtf(var + 1e-6f);
          *(unsigned*)(sCv + (tb + t) * 512 + c) = pk2(siluf(acc0[t] * rstd * g0 + bb0), siluf(acc1[t] * rstd * g1 + bb1));
        }
        __syncthreads();
#pragma unroll
        for (int i = 0; i < 4; ++i) {
          const int ch = tid + 256 * i; const int r = ch >> 6, c8 = (ch & 63) * 8;
          const int row = t0 + tb + r;
          const u32x4 yv = *(const u32x4*)(sCv + (tb + r) * 512 + c8);
          const u32x4 gw = *(const u32x4*)(UA + (size_t)row * 2464 + 1440 + 512 + c8);
          u32x4 o;
          o.x = pk2(bflo(yv.x) * siluf(bflo(gw.x)), bfhi(yv.x) * siluf(bfhi(gw.x)));
          o.y = pk2(bflo(yv.y) * siluf(bflo(gw.y)), bfhi(yv.y) * siluf(bfhi(gw.y)));
          o.z = pk2(bflo(yv.z) * siluf(bflo(gw.z)), bfhi(yv.z) * siluf(bfhi(gw.z)));
          o.w = pk2(bflo(yv.w) * siluf(bflo(gw.w)), bfhi(yv.w) * siluf(bfhi(gw.w)));
          *(u32x4*)(MIX + (size_t)row * 1024 + 512 + c8) = o;
        }
      }
    }
  }
}

DI void phase_attn(const Params& p, unsigned char* smem) {
  const int tid = threadIdx.x, lane = tid & 63, wave = tid >> 6, l31 = lane & 31, hf = lane >> 5;
  constexpr int ATT_SLOT = 64 * 104 + 64 * 72;
  bf16_t* sK0 = (bf16_t*)smem;
  bf16_t* sV0 = sK0 + 64 * 104;
  const bf16_t* Q = (const bf16_t*)(p.ws + WS_Q);
  const bf16_t* KN = (const bf16_t*)(p.ws + WS_KN);
  const bf16_t* KR = (const bf16_t*)(p.ws + WS_KR);
  const bf16_t* UA = (const bf16_t*)(p.ws + WS_UA);
  bf16_t* MIX = (bf16_t*)(p.ws + WS_MIX);
  const float SC = 0.10206207261596577f * 1.4426950408889634f;
  const bool xa = (gridDim.x & 7) == 0;
  const int axcd = blockIdx.x & 7, aper = xa ? 96 : 768, anb = xa ? (gridDim.x >> 3) : gridDim.x;
  for (int idx = xa ? (blockIdx.x >> 3) : blockIdx.x; idx < aper; idx += anb) {
    const int item = xa ? ((idx < 64) ? (axcd * 64 + idx) : (512 + axcd * 32 + (idx - 64))) : idx;
    int h, Lk, tok0, kvrow0; const bf16_t* vt;
    if (item < 512) {
      const int b = item >> 6; h = (item >> 3) & 7; const int qb = item & 7; Lk = 1536;
      tok0 = T_P + b * 1024 + qb * 128; kvrow0 = T_P + b * 1536;
      vt = (const bf16_t*)(p.ws + WS_VTS) + (size_t)(b * 8 + h) * 64 * 1536;
    } else {
      const int it = item - 512; const int b = it >> 4; h = (it >> 1) & 7; const int qb = it & 1; Lk = 256;
      tok0 = b * 256 + qb * 128; kvrow0 = b * 256;
      vt = (const bf16_t*)(p.ws + WS_VTP) + (size_t)(b * 8 + h) * 64 * 256;
    }
    const int token = tok0 + wave * 32 + l31;
    bf16x8 qf[6];
#pragma unroll
    for (int ks = 0; ks < 6; ++ks) qf[ks] = *(const bf16x8*)(Q + (size_t)token * 768 + h * 96 + ks * 16 + hf * 8);
    f32x16 O[2];
#pragma unroll
    for (int r = 0; r < 16; ++r) { O[0][r] = 0.f; O[1][r] = 0.f; }
    float m_run = -INFINITY, lsum = 0.f;
    u32x4 rkA[3], rvA[2], rkB[3], rvB[2];
    const int nkt = Lk >> 6;
    auto gload = [&](int kt, u32x4 (&rk)[3], u32x4 (&rv)[2]) {
      const int k0 = kt * 64;
#pragma unroll
      for (int i = 0; i < 3; ++i) {
        const int c = tid + 256 * i; const int key = c / 12, part = c - key * 12;
        const size_t kr = (size_t)(kvrow0 + k0 + key);
        rk[i] = (part < 8) ? *(const u32x4*)(KN + kr * 512 + h * 64 + part * 8) : *(const u32x4*)(KR + kr * 32 + (part - 8) * 8);
      }
#pragma unroll
      for (int i = 0; i < 2; ++i) {
        const int c = tid + 256 * i; const int d = c >> 3, part = c & 7;
        rv[i] = *(const u32x4*)(vt + (size_t)d * Lk + k0 + part * 8);
      }
    };
    auto lstore = [&](int slot, u32x4 (&rk)[3], u32x4 (&rv)[2]) {
      bf16_t* nK = sK0 + slot * ATT_SLOT;
      bf16_t* nV = sV0 + slot * ATT_SLOT;
#pragma unroll
      for (int i = 0; i < 3; ++i) { const int c = tid + 256 * i; const int key = c / 12, part = c - key * 12; *(u32x4*)(nK + key * 104 + part * 8) = rk[i]; }
#pragma unroll
      for (int i = 0; i < 2; ++i) { const int c = tid + 256 * i; const int d = c >> 3, part = c & 7; *(u32x4*)(nV + d * 72 + part * 8) = rv[i]; }
    };
    auto compute = [&](int slot) {
      const bf16_t* sK = sK0 + slot * ATT_SLOT;
      const bf16_t* sV = sV0 + slot * ATT_SLOT;
      f32x16 S[2];
#pragma unroll
      for (int sub = 0; sub < 2; ++sub) {
#pragma unroll
        for (int r = 0; r < 16; ++r) S[sub][r] = 0.f;
#pragma unroll
        for (int ks = 0; ks < 6; ++ks) {
          const bf16x8 a = *(const bf16x8*)(sK + (sub * 32 + l31) * 104 + ks * 16 + hf * 8);
          S[sub] = MFMA32(a, qf[ks], S[sub]);
        }
      }
      float mx = -INFINITY;
#pragma unroll
      for (int r = 0; r < 16; ++r) { mx = fmaxf(mx, S[0][r]); mx = fmaxf(mx, S[1][r]); }
      mx = fmaxf(mx, __shfl_xor(mx, 32));
      const float m_new = fmaxf(m_run, mx * SC);
      const float alpha = fexp2(m_run - m_new);
      m_run = m_new;
      float ps = 0.f;
#pragma unroll
      for (int sub = 0; sub < 2; ++sub)
#pragma unroll
        for (int r = 0; r < 16; ++r) { const float e = fexp2(S[sub][r] * SC - m_new); S[sub][r] = e; ps += e; }
      lsum = lsum * alpha + ps;
#pragma unroll
      for (int r = 0; r < 16; ++r) { O[0][r] *= alpha; O[1][r] *= alpha; }
#pragma unroll
      for (int sub = 0; sub < 2; ++sub)
#pragma unroll
        for (int s2 = 0; s2 < 2; ++s2) {
          u32x4 pw;
          pw.x = pk2(S[sub][8 * s2 + 0], S[sub][8 * s2 + 1]); pw.y = pk2(S[sub][8 * s2 + 2], S[sub][8 * s2 + 3]);
          pw.z = pk2(S[sub][8 * s2 + 4], S[sub][8 * s2 + 5]); pw.w = pk2(S[sub][8 * s2 + 6], S[sub][8 * s2 + 7]);
          const bf16x8 pf = __builtin_bit_cast(bf16x8, pw);
#pragma unroll
          for (int dt = 0; dt < 2; ++dt) {
            const bf16_t* vp = sV + (dt * 32 + l31) * 72 + sub * 32 + s2 * 16 + hf * 4;
            const u32x2 lo = *(const u32x2*)vp, hi = *(const u32x2*)(vp + 8);
            u32x4 aw; aw.x = lo.x; aw.y = lo.y; aw.z = hi.x; aw.w = hi.y;
            O[dt] = MFMA32(__builtin_bit_cast(bf16x8, aw), pf, O[dt]);
          }
        }
    };
    gload(0, rkA, rvA);
    __syncthreads();
    lstore(0, rkA, rvA);
    gload(1, rkA, rvA);
    gload(2, rkB, rvB);
    for (int kt = 0; kt < nkt; kt += 2) {
      __syncthreads();
      compute(0);
      lstore(1, rkA, rvA);
      if (kt + 3 < nkt) gload(kt + 3, rkA, rvA);
      __syncthreads();
      compute(1);
      if (kt + 2 < nkt) { lstore(0, rkB, rvB); if (kt + 4 < nkt) gload(kt + 4, rkB, rvB); }
    }
    lsum += __shfl_xor(lsum, 32);
    const float inv = 1.f / lsum;
    __syncthreads();
    {
      float* sT = (float*)smem + wave * (32 * 68);
#pragma unroll
      for (int dt = 0; dt < 2; ++dt)
#pragma unroll
        for (int q4 = 0; q4 < 4; ++q4) {
          f32x4 v = {O[dt][4 * q4] * inv, O[dt][4 * q4 + 1] * inv, O[dt][4 * q4 + 2] * inv, O[dt][4 * q4 + 3] * inv};
          *(f32x4*)(sT + l31 * 68 + dt * 32 + 8 * q4 + 4 * hf) = v;
        }
      const int trow0 = tok0 + wave * 32;
      tile_rowwise8f<8>(sT, lane, [=](int row, int col, f32x4 v, f32x4 w) {
        const size_t tk = (size_t)(trow0 + row);
        const u32x4 gw = *(const u32x4*)(UA + tk * 2464 + 1440 + h * 64 + col);
        u32x4 o;
        o.x = pk2(v.x * siluf(bflo(gw.x)), v.y * siluf(bfhi(gw.x)));
        o.y = pk2(v.z * siluf(bflo(gw.y)), v.w * siluf(bfhi(gw.y)));
        o.z = pk2(w.x * siluf(bflo(gw.z)), w.y * siluf(bfhi(gw.z)));
        o.w = pk2(w.z * siluf(bflo(gw.w)), w.w * siluf(bfhi(gw.w)));
        *(u32x4*)(MIX + tk * 1024 + h * 64 + col) = o;
      });
    }
  }
}

DI void phase_conv5(const Params& p) {
  const int tid = threadIdx.x;
  const bf16_t* RAWB = (const bf16_t*)(p.ws + WS_XBCR);
  bf16_t* XC = (bf16_t*)(p.ws + WS_XBC);
  const float* cw = p.in[23];
  const float* cb = p.in[24];
  const int c = tid * 12;
  float w[5][12], bias[12];
#pragma unroll
  for (int k = 0; k < 5; ++k)
#pragma unroll
    for (int q = 0; q < 3; ++q) {
      const f32x4 a = *(const f32x4*)(cw + k * 3072 + c + 4 * q);
      w[k][4 * q] = a.x; w[k][4 * q + 1] = a.y; w[k][4 * q + 2] = a.z; w[k][4 * q + 3] = a.w;
    }
#pragma unroll
  for (int q = 0; q < 3; ++q) {
    const f32x4 a = *(const f32x4*)(cb + c + 4 * q);
    bias[4 * q] = a.x; bias[4 * q + 1] = a.y; bias[4 * q + 2] = a.z; bias[4 * q + 3] = a.w;
  }
  for (int item = blockIdx.x; item < 384; item += gridDim.x) {
    const int wt = item >> 1, side = item & 1;
    const int row0 = wt * 64;
    int s0, s1;
    if (row0 < T_P) { s0 = row0 & ~255; s1 = s0 + 256; } else { s0 = T_P + ((row0 - T_P) & ~1023); s1 = s0 + 1024; }
    unsigned raw[6][6];
#pragma unroll
    for (int r = 0; r < 6; ++r) {
      const int grow = side ? (row0 + 60 + r) : (row0 - 2 + r);
      u32x2 u0 = {0u, 0u}, u1 = {0u, 0u}, u2 = {0u, 0u};
      if (grow >= s0 && grow < s1) {
        const int tw = grow >> 6, rr = grow & 63;
        const int rb = (rr < 4) ? rr : rr - 56;
        const u32x2* sp = (const u32x2*)(RAWB + ((size_t)(tw * 8 + rb)) * 3072 + c);
        u0 = sp[0]; u1 = sp[1]; u2 = sp[2];
      }
      raw[r][0] = u0.x; raw[r][1] = u0.y; raw[r][2] = u1.x; raw[r][3] = u1.y; raw[r][4] = u2.x; raw[r][5] = u2.y;
    }
#pragma unroll
    for (int t = 0; t < 2; ++t) {
      float a[12];
#pragma unroll
      for (int e = 0; e < 12; ++e) a[e] = bias[e];
#pragma unroll
      for (int k = 0; k < 5; ++k)
#pragma unroll
        for (int d = 0; d < 6; ++d) {
          const unsigned u = raw[t + k][d];
          a[2 * d] += bflo(u) * w[k][2 * d]; a[2 * d + 1] += bfhi(u) * w[k][2 * d + 1];
        }
      u32x2 o[3];
#pragma unroll
      for (int q = 0; q < 3; ++q) { o[q].x = pk2(siluf(a[4 * q]), siluf(a[4 * q + 1])); o[q].y = pk2(siluf(a[4 * q + 2]), siluf(a[4 * q + 3])); }
      const int orow = side ? (row0 + 62 + t) : (row0 + t);
      u32x2* dp = (u32x2*)(XC + (size_t)orow * 3072 + c);
      dp[0] = o[0]; dp[1] = o[1]; dp[2] = o[2];
    }
  }
}

DI void phase_scan(const Params& p, unsigned char* smem) {
  const int tid = threadIdx.x, lane = tid & 63, wave = tid >> 6, l31 = lane & 31, hf = lane >> 5;
  bf16_t* sB = (bf16_t*)smem;
  bf16_t* sXT = sB + 128 * 136;
  bf16_t* sS = sXT + 64 * 136;
  float* sAc = (float*)(sS + 64 * 136);
  float* sDt = sAc + 128;
  float* sWg = sDt + 128;
  float* sTot = sWg + 128;
  bf16_t* sYst = (bf16_t*)(sTot + 4);
  const bf16_t* XC = (const bf16_t*)(p.ws + WS_XBC);
  const float* DT = (const float*)(p.ws + WS_DT);
  const float LOG2E = 1.4426950408889634f;
  const int lt = (blockIdx.x * 2 >= gridDim.x) ? 3 - wave : wave;
  int nb, j0, xcd;
  if ((gridDim.x & 7) == 0) { xcd = blockIdx.x & 7; j0 = blockIdx.x >> 3; nb = gridDim.x >> 3; }
  else { xcd = 0; j0 = blockIdx.x; nb = gridDim.x; }
  const int per = ((gridDim.x & 7) == 0) ? 192 : 1536;
  for (int idx = j0; idx < per; idx += nb) {
    int item;
    if ((gridDim.x & 7) == 0) item = (idx < 64) ? (xcd * 64 + idx) : (512 + xcd * 128 + (idx - 64));
    else item = idx;
    const bool smp = item < 512;
    const int it = smp ? item : item - 512;
    const int e8 = it & 7, g = (it >> 3) & 3, dir = (it >> 5) & 1, b = it >> 6, h = g * 8 + e8;
    const int L = smp ? 1024 : 256, nc = L >> 7;
    const int tokbase = smp ? (T_P + b * 1024) : (b * 256);
    const float a_neg = -fexp(p.in[26][dir * 32 + h]) * LOG2E;
    const float dsk = p.in[27][h];
    bf16_t* Y = (bf16_t*)(p.ws + (dir ? WS_YB : WS_YF));
    f32x16 accS[2];
    if (smp) {
      const float* st = p.in[4] + ((size_t)(b * 2 + dir) * 32 + h) * 8192;
#pragma unroll
      for (int pt = 0; pt < 2; ++pt)
#pragma unroll
        for (int q4 = 0; q4 < 4; ++q4) {
          const f32x4 v4 = *(const f32x4*)(st + (pt * 32 + l31) * 128 + wave * 32 + 8 * q4 + 4 * hf);
          accS[pt][4 * q4] = v4.x; accS[pt][4 * q4 + 1] = v4.y; accS[pt][4 * q4 + 2] = v4.z; accS[pt][4 * q4 + 3] = v4.w;
        }
    } else {
#pragma unroll
      for (int pt = 0; pt < 2; ++pt)
#pragma unroll
        for (int r = 0; r < 16; ++r) accS[pt][r] = 0.f;
    }
    u32x4 rB[8], rX[4]; float rdt = 0.f; bf16x8 cf[8];
    auto prefetch = [&](int c) {
#pragma unroll
      for (int i = 0; i < 8; ++i) {
        const int ch = tid + 256 * i; const int r = ch >> 4, part = ch & 15;
        const int pos = c * 128 + r; const int tok = tokbase + (dir ? (L - 1 - pos) : pos);
        rB[i] = *(const u32x4*)(XC + (size_t)tok * 3072 + 2048 + g * 128 + part * 8);
      }
#if PF_X
#pragma unroll
      for (int i = 0; i < 4; ++i) {
        const int ch = tid + 256 * i; const int r = ch & 127, part = ch >> 7;
        const int pos = c * 128 + r; const int tok = tokbase + (dir ? (L - 1 - pos) : pos);
        rX[i] = *(const u32x4*)(XC + (size_t)tok * 3072 + h * 64 + part * 8);
      }
#endif
      if (tid < 128) {
        const int pos = c * 128 + tid; const int tok = tokbase + (dir ? (L - 1 - pos) : pos);
        rdt = DT[(size_t)tok * 64 + dir * 32 + h];
      }
    };
    auto load_cf = [&](int c) {
      const int pos = c * 128 + lt * 32 + l31; const int tok = tokbase + (dir ? (L - 1 - pos) : pos);
      const bf16_t* cp = XC + (size_t)tok * 3072 + 2560 + g * 128 + hf * 8;
#pragma unroll
      for (int ks = 0; ks < 8; ++ks) cf[ks] = *(const bf16x8*)(cp + ks * 16);
    };
    prefetch(0);
#if PF_C
    load_cf(0);
#endif
    __syncthreads();
#pragma unroll
    for (int pt = 0; pt < 2; ++pt)
#pragma unroll
      for (int q4 = 0; q4 < 4; ++q4) {
        u32x2 o; o.x = pk2(accS[pt][4 * q4], accS[pt][4 * q4 + 1]); o.y = pk2(accS[pt][4 * q4 + 2], accS[pt][4 * q4 + 3]);
        *(u32x2*)(sS + (pt * 32 + l31) * 136 + wave * 32 + 8 * q4 + 4 * hf) = o;
      }

    for (int c = 0; c < nc; ++c) {
#if !PF_C
      load_cf(c);
#endif
#pragma unroll
      for (int i = 0; i < 8; ++i) { const int ch = tid + 256 * i; const int r = ch >> 4, part = ch & 15; *(u32x4*)(sB + r * 136 + part * 8) = rB[i]; }
#if !PF_X
#pragma unroll
      for (int i = 0; i < 4; ++i) {
        const int ch = tid + 256 * i; const int r = ch & 127, part = ch >> 7;
        const int pos = c * 128 + r; const int tok = tokbase + (dir ? (L - 1 - pos) : pos);
        rX[i] = *(const u32x4*)(XC + (size_t)tok * 3072 + h * 64 + part * 8);
      }
#endif
#pragma unroll
      for (int i = 0; i < 4; ++i) {
        const int ch = tid + 256 * i; const int r = ch & 127, part = ch >> 7;
        const u32x4 v = rX[i];
        bf16_t* d = sXT + (part * 8) * 136 + r;
        d[0] = (bf16_t)(v.x & 0xffff); d[136] = (bf16_t)(v.x >> 16);
        d[2 * 136] = (bf16_t)(v.y & 0xffff); d[3 * 136] = (bf16_t)(v.y >> 16);
        d[4 * 136] = (bf16_t)(v.z & 0xffff); d[5 * 136] = (bf16_t)(v.z >> 16);
        d[6 * 136] = (bf16_t)(v.w & 0xffff); d[7 * 136] = (bf16_t)(v.w >> 16);
      }
      const float dtv = rdt;
      float v = (tid < 128) ? dtv * a_neg : 0.f;
#pragma unroll
      for (int o = 1; o < 64; o <<= 1) { const float t = __shfl_up(v, o); if (lane >= o) v += t; }
      if (lane == 63) sTot[wave] = v;
      __syncthreads();
      if (wave == 1) v += sTot[0];
      if (tid < 128) { sAc[tid] = v; sDt[tid] = dtv; }
      __syncthreads();
      const float a_last = sAc[127];
      if (tid < 128) sWg[tid] = dtv * fexp2(a_last - v);
      const float acl = sAc[lt * 32 + l31];
      const float ea_l = fexp2(acl);
      f32x16 accY[2];
#pragma unroll
      for (int pt = 0; pt < 2; ++pt) {
#pragma unroll
        for (int r = 0; r < 16; ++r) accY[pt][r] = 0.f;
#pragma unroll
        for (int ks = 0; ks < 8; ++ks) {
          const bf16x8 a = *(const bf16x8*)(sS + (pt * 32 + l31) * 136 + ks * 16 + hf * 8);
          accY[pt] = MFMA32(a, cf[ks], accY[pt]);
        }
#pragma unroll
        for (int r = 0; r < 16; ++r) accY[pt][r] *= ea_l;
      }
      float* sw2 = (float*)(sYst + wave * (32 * 40));
      float el = 0.f;
      if (lt > 0) {
        const float a_ref = sAc[lt * 32 - 1];
        el = fexp2(acl - a_ref);
        for (int sidx = lane; sidx < lt * 32; sidx += 64) sw2[sidx] = fexp2(a_ref - sAc[sidx]) * sDt[sidx];
      }
      auto diag_tile = [&](int st, auto diag_tag) {
        constexpr bool DIAG = decltype(diag_tag)::value;
        f32x16 cbT;
#pragma unroll
        for (int r = 0; r < 16; ++r) cbT[r] = 0.f;
#pragma unroll
        for (int ks = 0; ks < 8; ++ks) {
          const bf16x8 a = *(const bf16x8*)(sB + (st * 32 + l31) * 136 + ks * 16 + hf * 8);
          cbT = MFMA32(a, cf[ks], cbT);
        }
        const int lrow = lt * 32 + l31;
        if (!DIAG) {
#pragma unroll
          for (int q4 = 0; q4 < 4; ++q4) {
            const f32x4 w4 = *(const f32x4*)(sw2 + st * 32 + 8 * q4 + 4 * hf);
            cbT[4 * q4 + 0] *= el * w4.x; cbT[4 * q4 + 1] *= el * w4.y; cbT[4 * q4 + 2] *= el * w4.z; cbT[4 * q4 + 3] *= el * w4.w;
          }
        } else {
#pragma unroll 1
          for (int q4h = 0; q4h < 2; ++q4h)
#pragma unroll
          for (int q4 = 2 * q4h; q4 < 2 * q4h + 2; ++q4) {
            const int sbase = st * 32 + 8 * q4 + 4 * hf;
            const f32x4 ac4 = *(const f32x4*)(sAc + sbase);
            const f32x4 dt4 = *(const f32x4*)(sDt + sbase);
            cbT[4 * q4 + 0] = (sbase + 0 <= lrow) ? cbT[4 * q4 + 0] * fexp2(acl - ac4.x) * dt4.x : 0.f;
            cbT[4 * q4 + 1] = (sbase + 1 <= lrow) ? cbT[4 * q4 + 1] * fexp2(acl - ac4.y) * dt4.y : 0.f;
            cbT[4 * q4 + 2] = (sbase + 2 <= lrow) ? cbT[4 * q4 + 2] * fexp2(acl - ac4.z) * dt4.z : 0.f;
            cbT[4 * q4 + 3] = (sbase + 3 <= lrow) ? cbT[4 * q4 + 3] * fexp2(acl - ac4.w) * dt4.w : 0.f;
          }
        }
#pragma unroll
        for (int s2 = 0; s2 < 2; ++s2) {
          u32x4 pw;
          pw.x = pk2(cbT[8 * s2 + 0], cbT[8 * s2 + 1]); pw.y = pk2(cbT[8 * s2 + 2], cbT[8 * s2 + 3]);
          pw.z = pk2(cbT[8 * s2 + 4], cbT[8 * s2 + 5]); pw.w = pk2(cbT[8 * s2 + 6], cbT[8 * s2 + 7]);
          const bf16x8 pf = __builtin_bit_cast(bf16x8, pw);
#pragma unroll
          for (int pt = 0; pt < 2; ++pt) {
            const bf16_t* xp = sXT + (pt * 32 + l31) * 136 + st * 32 + s2 * 16 + hf * 4;
            const u32x2 lo = *(const u32x2*)xp, hi = *(const u32x2*)(xp + 8);
            u32x4 aw; aw.x = lo.x; aw.y = lo.y; aw.z = hi.x; aw.w = hi.y;
            accY[pt] = MFMA32(__builtin_bit_cast(bf16x8, aw), pf, accY[pt]);
          }
        }
      };
      for (int st = 0; st < lt; ++st) diag_tile(st, std::false_type{});
      diag_tile(lt, std::true_type{});
      {
        bf16_t* yst = sYst + wave * (32 * 40);
#pragma unroll
        for (int pt = 0; pt < 2; ++pt) {
#pragma unroll
          for (int q4 = 0; q4 < 4; ++q4) {
            u32x2 o; o.x = pk2(accY[pt][4 * q4], accY[pt][4 * q4 + 1]); o.y = pk2(accY[pt][4 * q4 + 2], accY[pt][4 * q4 + 3]);
            *(u32x2*)(yst + l31 * 40 + 8 * q4 + 4 * hf) = o;
          }
#pragma unroll
          for (int it = 0; it < 2; ++it) {
            const int row = (lane >> 2) + 16 * it, chunk = lane & 3;
            const u32x4 v4 = *(const u32x4*)(yst + row * 40 + chunk * 8);
            const int pos = c * 128 + lt * 32 + row; const int tok = tokbase + (dir ? (L - 1 - pos) : pos);
            u32x4 o4 = v4;
            if (dir == 0) {
              const u32x4 xv = *(const u32x4*)(XC + (size_t)tok * 3072 + h * 64 + pt * 32 + chunk * 8);
              o4.x = pk2(bflo(v4.x) + dsk * bflo(xv.x), bfhi(v4.x) + dsk * bfhi(xv.x));
              o4.y = pk2(bflo(v4.y) + dsk * bflo(xv.y), bfhi(v4.y) + dsk * bfhi(xv.y));
              o4.z = pk2(bflo(v4.z) + dsk * bflo(xv.z), bfhi(v4.z) + dsk * bfhi(xv.z));
              o4.w = pk2(bflo(v4.w) + dsk * bflo(xv.w), bfhi(v4.w) + dsk * bfhi(xv.w));
            }
            *(u32x4*)(Y + (size_t)tok * 2048 + h * 64 + pt * 32 + chunk * 8) = o4;
          }
        }
      }
      __syncthreads();
      if (c + 1 < nc) {
        prefetch(c + 1);
#if PF_C
        load_cf(c + 1);
#endif
      }
      {
        const float dec = fexp2(a_last);
#pragma unroll
        for (int pt = 0; pt < 2; ++pt)
#pragma unroll
          for (int r = 0; r < 16; ++r) accS[pt][r] *= dec;
#pragma unroll 2
        for (int ks = 0; ks < 8; ++ks) {
          const int sb = ks * 16 + hf * 8;
          const f32x4 w0 = *(const f32x4*)(sWg + sb), w1 = *(const f32x4*)(sWg + sb + 4);
          const bf16_t* bp = sB + sb * 136 + wave * 32 + l31;
          u32x4 bw;
          bw.x = pk2(bf2f(bp[0]) * w0.x, bf2f(bp[136]) * w0.y);
          bw.y = pk2(bf2f(bp[2 * 136]) * w0.z, bf2f(bp[3 * 136]) * w0.w);
          bw.z = pk2(bf2f(bp[4 * 136]) * w1.x, bf2f(bp[5 * 136]) * w1.y);
          bw.w = pk2(bf2f(bp[6 * 136]) * w1.z, bf2f(bp[7 * 136]) * w1.w);
          const bf16x8 bfrag = __builtin_bit_cast(bf16x8, bw);
#pragma unroll
          for (int pt = 0; pt < 2; ++pt) {
            const bf16x8 a = *(const bf16x8*)(sXT + (pt * 32 + l31) * 136 + ks * 16 + hf * 8);
            accS[pt] = MFMA32(bfrag, a, accS[pt]);
          }
        }
      }
#pragma unroll
      for (int pt = 0; pt < 2; ++pt)
#pragma unroll
        for (int q4 = 0; q4 < 4; ++q4) {
          u32x2 o; o.x = pk2(accS[pt][4 * q4], accS[pt][4 * q4 + 1]); o.y = pk2(accS[pt][4 * q4 + 2], accS[pt][4 * q4 + 3]);
          *(u32x2*)(sS + (pt * 32 + l31) * 136 + wave * 32 + 8 * q4 + 4 * hf) = o;
        }
      __syncthreads();
    }
    if (!smp) {
      float* o = p.out + OUT_ST + ((size_t)(b * 2 + dir) * 32 + h) * 8192;
#pragma unroll
      for (int pt = 0; pt < 2; ++pt)
#pragma unroll
        for (int q4 = 0; q4 < 4; ++q4) {
          f32x4 v4 = {accS[pt][4 * q4], accS[pt][4 * q4 + 1], accS[pt][4 * q4 + 2], accS[pt][4 * q4 + 3]};
          *(f32x4*)(o + (pt * 32 + l31) * 128 + wave * 32 + 8 * q4 + 4 * hf) = v4;
        }
    }
  }
}

DI void phase_combine(const Params& p) {
  const int tid = threadIdx.x, lane = tid & 63, wave = tid >> 6;
  const bf16_t* YF = (const bf16_t*)(p.ws + WS_YF);
  const bf16_t* YB = (const bf16_t*)(p.ws + WS_YB);
  const bf16_t* XC = (const bf16_t*)(p.ws + WS_XBC);
  bf16_t* Z = (bf16_t*)(p.ws + WS_Z);
  const float* dsk = p.in[27];
  const float* gn = p.in[28];
  for (int row = blockIdx.x * 4 + wave; row < T_ALL; row += gridDim.x * 4) {
    float v[32]; float ss = 0.f;
#pragma unroll
    for (int j = 0; j < 4; ++j) {
      const int c = lane * 8 + 512 * j;
      const u32x4 yf = *(const u32x4*)(YF + (size_t)row * 2048 + c);
      const u32x4 yb = *(const u32x4*)(YB + (size_t)row * 2048 + c);
      const u32x4 z = *(const u32x4*)(Z + (size_t)row * 2048 + c);
      const unsigned yfw[4] = {yf.x, yf.y, yf.z, yf.w}, ybw[4] = {yb.x, yb.y, yb.z, yb.w}, zw[4] = {z.x, z.y, z.z, z.w};
#pragma unroll
      for (int e = 0; e < 4; ++e) {
        const float a = (bflo(yfw[e]) + bflo(ybw[e])) * siluf(bflo(zw[e]));
        const float b = (bfhi(yfw[e]) + bfhi(ybw[e])) * siluf(bfhi(zw[e]));
        v[j * 8 + 2 * e] = a; v[j * 8 + 2 * e + 1] = b; ss += a * a + b * b;
      }
    }
    ss = wave_sum(ss);
    const float rstd = rsqrtf(ss * (1.f / 2048.f) + 1e-6f);
#pragma unroll
    for (int j = 0; j < 4; ++j) {
      const int c = lane * 8 + 512 * j;
      const f32x4 g0 = *(const f32x4*)(gn + c), g1 = *(const f32x4*)(gn + c + 4);
      u32x4 o;
      o.x = pk2(v[j * 8 + 0] * rstd * g0.x, v[j * 8 + 1] * rstd * g0.y);
      o.y = pk2(v[j * 8 + 2] * rstd * g0.z, v[j * 8 + 3] * rstd * g0.w);
      o.z = pk2(v[j * 8 + 4] * rstd * g1.x, v[j * 8 + 5] * rstd * g1.y);
      o.w = pk2(v[j * 8 + 6] * rstd * g1.z, v[j * 8 + 7] * rstd * g1.w);
      *(u32x4*)(Z + (size_t)row * 2048 + c) = o;
    }
  }
}

DI void phase_final(const Params& p) {
  const int tid = threadIdx.x, lane = tid & 63, wave = tid >> 6;
  const float* g = p.in[10];
  const bf16_t* X2 = (const bf16_t*)(p.ws + WS_X2);
  const int nw = gridDim.x * 4;
  for (int row = blockIdx.x * 4 + wave; row < T_ALL; row += 2 * nw) {
    const int row2 = row + nw;
    const bool has2 = row2 < T_ALL;
    const int rb = has2 ? row2 : row;
    u32x4 a[2], b[2];
#pragma unroll
    for (int jj = 0; jj < 2; ++jj) { a[jj] = *(const u32x4*)(X2 + (size_t)row * 1024 + lane * 8 + 512 * jj); b[jj] = *(const u32x4*)(X2 + (size_t)rb * 1024 + lane * 8 + 512 * jj); }
    float va[16], vb[16]; float ss = 0.f, ss2 = 0.f;
#pragma unroll
    for (int jj = 0; jj < 2; ++jj) {
      const unsigned aw[4] = {a[jj].x, a[jj].y, a[jj].z, a[jj].w}, bw[4] = {b[jj].x, b[jj].y, b[jj].z, b[jj].w};
#pragma unroll
      for (int e = 0; e < 4; ++e) {
        va[jj * 8 + 2 * e] = bflo(aw[e]); va[jj * 8 + 2 * e + 1] = bfhi(aw[e]);
        vb[jj * 8 + 2 * e] = bflo(bw[e]); vb[jj * 8 + 2 * e + 1] = bfhi(bw[e]);
      }
    }
#pragma unroll
    for (int i = 0; i < 16; ++i) { ss += va[i] * va[i]; ss2 += vb[i] * vb[i]; }
    ss = wave_sum(ss); ss2 = wave_sum(ss2);
    const float rstd = rsqrtf(ss * (1.f / 1024.f) + 1e-6f), rstd2 = rsqrtf(ss2 * (1.f / 1024.f) + 1e-6f);
    float* yr = p.out + OUT_Y + (size_t)row * 1024;
    float* yr2 = p.out + OUT_Y + (size_t)rb * 1024;
#pragma unroll
    for (int jj = 0; jj < 2; ++jj)
#pragma unroll
      for (int hq = 0; hq < 2; ++hq) {
        const int c = lane * 8 + 512 * jj + 4 * hq;
        const f32x4 gg = *(const f32x4*)(g + c);
        const int i0 = jj * 8 + hq * 4;
        f32x4 o = {va[i0] * rstd * gg.x, va[i0 + 1] * rstd * gg.y, va[i0 + 2] * rstd * gg.z, va[i0 + 3] * rstd * gg.w};
        *(f32x4*)(yr + c) = o;
        if (has2) {
          f32x4 o2 = {vb[i0] * rstd2 * gg.x, vb[i0 + 1] * rstd2 * gg.y, vb[i0 + 2] * rstd2 * gg.z, vb[i0 + 3] * rstd2 * gg.w};
          *(f32x4*)(yr2 + c) = o2;
        }
      }
  }
}

constexpr int N_PHASES = 14;
#ifndef PHASE_ONLY
#define PHASE_ONLY -1
#endif
#define PH_EN(k) (PHASE_ONLY < 0 || PHASE_ONLY == (k))

#ifndef DUP_MASK
#define DUP_MASK 0
#endif
#define RUN_PHASE(k, ...) if (PH_EN(k) && ph_lo <= (k) && (k) < ph_hi) { if ((k) > ph_lo) xcd_barrier(xb); __VA_ARGS__ \
    if ((DUP_MASK >> (k)) & 1) { xcd_barrier(xb); __VA_ARGS__ } }

__global__ void __launch_bounds__(NTHR, 2) mega(Params p, int ph_lo, int ph_hi) {
  extern __shared__ __attribute__((aligned(16))) unsigned char smem[];
  volatile LAS unsigned* xst = (volatile LAS unsigned*)(smem + LDS_BYTES - 16);
  if (threadIdx.x == 0) { xst[0] = 0u; xst[1] = 0u; xst[2] = 0u; xst[3] = 0u; }
  __syncthreads();
  XcdBarrier xb = xcd_barrier_post((unsigned*)(p.ws + WS_BAR), xst);
  if (ph_hi > 1000) cg::this_grid().sync();
  RUN_PHASE(0, phase0(p, smem);)
  RUN_PHASE(1, phase_h(p, 0, p.in[0], p.in[1], nullptr, (bf16_t*)(p.ws + WS_H0), smem);)
  RUN_PHASE(2, {
    EpiAin e{(bf16_t*)(p.ws + WS_UA)};
    gemm_phase<true>((const bf16_t*)(p.ws + WS_H0), 1024, (const bf16_t*)(p.ws + WS_WT_AIN), 1024, 1024, 96, 20, smem, e);
  })
  RUN_PHASE(3, phase3(p, smem);)
  RUN_PHASE(4, {
    EpiQ eq{(bf16_t*)(p.ws + WS_Q), (const float*)(p.ws + WS_ROPE)};
    gemm_phase<true>((const bf16_t*)(p.ws + WS_QN), 256, (const bf16_t*)(p.ws + WS_WT_UQ), 256, 256, 96, 6, smem, eq);
    EpiKV ek{(bf16_t*)(p.ws + WS_KN), (bf16_t*)(p.ws + WS_VTP), (bf16_t*)(p.ws + WS_VTS)};
    gemm_phase<true>((const bf16_t*)(p.ws + WS_CKV), 128, (const bf16_t*)(p.ws + WS_WT_UKV), 128, 128, 128, 8, smem, ek);
  })
  RUN_PHASE(5, phase_attn(p, smem);)
  RUN_PHASE(6, {
    EpiRes e{(const float*)(p.ws + WS_MODP), 0, p.in[0], p.in[1], nullptr, (bf16_t*)(p.out + OUT_Y), nullptr, 0};
    gemm_phase<true>((const bf16_t*)(p.ws + WS_MIX), 1024, (const bf16_t*)(p.ws + WS_WT_AOUT), 1024, 1024, 96, 8, smem, e);
    if ((gridDim.x & 7) == 0 && gridDim.x == 512) { const int j = blockIdx.x >> 3; if (j >= 32) convert_c_weights(p, (j - 32) * 8 + (blockIdx.x & 7), 256, smem); }
    else convert_c_weights(p, blockIdx.x, gridDim.x, smem);
  })
  RUN_PHASE(7, phase_h(p, 1, nullptr, nullptr, (const bf16_t*)(p.out + OUT_Y), (bf16_t*)(p.ws + WS_H1), smem);)
  RUN_PHASE(8, {
    EpiCin e{(bf16_t*)(p.ws + WS_Z), (bf16_t*)(p.ws + WS_XBCR)  , (bf16_t*)(p.ws + WS_XBC), (float*)(p.ws + WS_DT), p.in[25], p.in[23], p.in[24]};
    gemm_phase<true>((const bf16_t*)(p.ws + WS_H1), 1024, (const bf16_t*)(p.ws + WS_WT_CIN), 1024, 1024, 96, 41, smem, e);
  })
  RUN_PHASE(9, phase_conv5(p);)
  RUN_PHASE(10, phase_scan(p, smem);)
  RUN_PHASE(11, phase_combine(p);)
  RUN_PHASE(12, {
    EpiRes e{(const float*)(p.ws + WS_MODP), 1, nullptr, nullptr, (const bf16_t*)(p.out + OUT_Y), (bf16_t*)(p.ws + WS_X2), nullptr, 0};
    gemm_phase<true, 2>((const bf16_t*)(p.ws + WS_Z), 2048, (const bf16_t*)(p.ws + WS_WT_COUT), 2048, 1024, 96, 8, smem, e);
  })
  RUN_PHASE(13, phase_final(p);)
}

extern "C" void kernel_launch(void* const* d_in, const int* in_sizes, int n_in, void* d_out, int out_size,
                              void* d_ws, size_t ws_size, hipStream_t stream) {
  static int grid_blocks = 0;
  if (grid_blocks == 0) {
    if (n_in != 30 || ws_size < WS_NEED) {
      fprintf(stderr, "kernel_launch: expected 30 inputs and >= %zu B of workspace, got %d / %zu\n", (size_t)WS_NEED, n_in, ws_size);
      grid_blocks = -1; return;
    }
    int dev = 0, cus = 0, per_cu = 0;
    hipGetDevice(&dev);
    hipDeviceGetAttribute(&cus, hipDeviceAttributeMultiprocessorCount, dev);
    if (hipFuncSetAttribute((const void*)mega, hipFuncAttributeMaxDynamicSharedMemorySize, LDS_BYTES) != hipSuccess)
      fprintf(stderr, "kernel_launch: hipFuncSetAttribute failed\n");
    if (hipOccupancyMaxActiveBlocksPerMultiprocessor(&per_cu, (const void*)mega, NTHR, LDS_BYTES) != hipSuccess || per_cu < 1) {
      fprintf(stderr, "kernel_launch: occupancy query failed (%d)\n", per_cu);
      per_cu = 1;
    }
    if (per_cu > 2) per_cu = 2;
    grid_blocks = cus * per_cu;
    (void)hipGetLastError();
  }
  if (grid_blocks < 0) return;
  Params p{};
  for (int i = 0; i < 30; ++i) p.in[i] = (const float*)d_in[i];
  p.out = (float*)d_out;
  p.ws = (unsigned char*)d_ws;
#if ONE_LAUNCH
  if (hipMemsetAsync((unsigned char*)d_ws + WS_BAR, 0, XCD_BAR_WORDS * 4, stream) != hipSuccess) fprintf(stderr, "kernel_launch: memset of barrier words failed\n");
  int lo = 0, hi = N_PHASES;
  void* args[] = {&p, &lo, &hi};
  hipError_t e = hipLaunchCooperativeKernel((const void*)mega, dim3(grid_blocks), dim3(NTHR), args, LDS_BYTES, stream);
  if (e != hipSuccess) fprintf(stderr, "cooperative launch failed: %s (grid %d)\n", hipGetErrorString(e), grid_blocks);
#else
  for (int ph = 0; ph < N_PHASES; ++ph) {
    hipLaunchKernelGGL(mega, dim3(grid_blocks), dim3(NTHR), LDS_BYTES, stream, p, ph, ph + 1);
  }
#endif
}
```

```cpp
#include <hip/hip_runtime.h>
#include <hip/hip_cooperative_groups.h>
#include <cstdio>
#include <cstdint>
#include <type_traits>
namespace cg = cooperative_groups;

#ifndef PF_C
#define PF_C 1
#endif
#ifndef PF_X
#define PF_X 0
#endif
#ifndef ONE_LAUNCH
#define ONE_LAUNCH 1
#endif

typedef unsigned short bf16_t;
typedef __attribute__((ext_vector_type(8))) short bf16x8;
typedef __attribute__((ext_vector_type(4))) short bf16x4;
typedef __attribute__((ext_vector_type(16))) float f32x16;
typedef __attribute__((ext_vector_type(4))) float f32x4;
typedef __attribute__((ext_vector_type(4))) unsigned u32x4;
typedef __attribute__((ext_vector_type(2))) unsigned u32x2;

#define DI __device__ __forceinline__
#define MFMA32(a, b, c) __builtin_amdgcn_mfma_f32_32x32x16_bf16((a), (b), (c), 0, 0, 0)

constexpr int NTHR = 256;
constexpr int LDS_BYTES = 80 * 1024;
constexpr int T_P = 4096, T_ALL = 12288;
constexpr int KVROWS = 16384;

constexpr size_t WS_WT_AIN  = 0;
constexpr size_t WS_WT_UQ   = WS_WT_AIN + 2560ull * 1024 * 2;
constexpr size_t WS_WT_UKV  = WS_WT_UQ + 768ull * 256 * 2;
constexpr size_t WS_WT_AOUT = WS_WT_UKV + 1024ull * 128 * 2;
constexpr size_t WS_WT_CIN  = WS_WT_AOUT + 1024ull * 1024 * 2;
constexpr size_t WS_WT_COUT = WS_WT_CIN + 5248ull * 1024 * 2;
constexpr size_t WS_MODP    = WS_WT_COUT + 1024ull * 2048 * 2;
constexpr size_t WS_ROPE    = WS_MODP + 8ull * 2 * 9 * 3072 * 4;
constexpr size_t WS_BAR     = WS_ROPE + 1024ull * 16 * 2 * 4;
constexpr size_t WS_R       = 24ull * 1024 * 1024;
static_assert(WS_BAR + 16384 <= WS_R, "persistent region overflow");
constexpr size_t WS_H0  = WS_R;
constexpr size_t WS_UA  = WS_H0 + 12288ull * 1024 * 2;
constexpr size_t WS_QN  = WS_UA + 12288ull * 2464 * 2;
constexpr size_t WS_Q   = WS_QN + 12288ull * 256 * 2;
constexpr size_t WS_CKV = WS_Q + 12288ull * 768 * 2;
constexpr size_t WS_KR  = WS_CKV + 16384ull * 128 * 2;
constexpr size_t WS_KN  = WS_KR + 16384ull * 32 * 2;
constexpr size_t WS_VTP = WS_KN + 16384ull * 512 * 2;
constexpr size_t WS_VTS = WS_VTP + 16ull * 8 * 64 * 256 * 2;
constexpr size_t WS_MIX = WS_VTS + 8ull * 8 * 64 * 1536 * 2;
constexpr size_t WS_A_END = WS_MIX + 12288ull * 1024 * 2;
constexpr size_t WS_Z    = WS_R;
constexpr size_t WS_XBCR = WS_Z + 12288ull * 2048 * 2;
constexpr size_t WS_H1   = WS_XBCR + 12288ull * 3072 * 2;
constexpr size_t WS_XBC  = WS_H1 + 12288ull * 1024 * 2;
constexpr size_t WS_DT   = WS_XBC + 12288ull * 3072 * 2;
constexpr size_t WS_C_END = WS_DT + 12288ull * 64 * 4;
constexpr size_t WS_YF   = WS_XBCR;
constexpr size_t WS_YB   = WS_YF + 12288ull * 2048 * 2;
constexpr size_t WS_X2   = WS_YF;
static_assert(WS_YB + 12288ull * 2048 * 2 == WS_XBC, "y alias mismatch");
constexpr size_t WS_NEED = (WS_A_END > WS_C_END ? WS_A_END : WS_C_END);
static_assert(WS_NEED <= 256ull * 1024 * 1024, "workspace too large");

constexpr size_t OUT_Y   = 0;
constexpr size_t OUT_CKV = 12288ull * 1024;
constexpr size_t OUT_KR  = OUT_CKV + 4096ull * 128;
constexpr size_t OUT_ST  = OUT_KR + 4096ull * 32;

struct Params {
  const float* in[30];
  float* out;
  unsigned char* ws;
};

typedef __bf16 hwbf2_t __attribute__((ext_vector_type(2)));
DI bf16_t f2bf(float f) { __bf16 v = (__bf16)f; return __builtin_bit_cast(bf16_t, v); }
DI float bf2f(unsigned h) { return __uint_as_float(h << 16); }
DI unsigned pk2(float a, float b) { hwbf2_t v = {(__bf16)a, (__bf16)b}; return __builtin_bit_cast(unsigned, v); }
DI float bflo(unsigned w) { return __uint_as_float(w << 16); }
DI float bfhi(unsigned w) { return __uint_as_float(w & 0xffff0000u); }
DI float fexp2(float x) { return __builtin_amdgcn_exp2f(x); }
DI float fexp(float x) { return __builtin_amdgcn_exp2f(x * 1.4426950408889634f); }
DI float frcp(float x) { return __builtin_amdgcn_rcpf(x); }
DI float siluf(float x) { return x * frcp(1.f + fexp(-x)); }
DI float sigmoidf_(float x) { return frcp(1.f + fexp(-x)); }
DI int crow(int r, int hf) { return (r & 3) + 8 * (r >> 2) + 4 * hf; }
DI float wave_sum(float v) {
#pragma unroll
  for (int o = 32; o > 0; o >>= 1) v += __shfl_xor(v, o);
  return v;
}
DI int cond_of_row(int row) { return row < T_P ? 0 : 1 + ((row - T_P) >> 10); }
DI float modp_sum(const float* modp, int layer, int cond, int j) {
  float s = 0.f;
#pragma unroll
  for (int kq = 0; kq < 8; ++kq) s += modp[((size_t)((kq * 2 + layer) * 9 + cond)) * 3072 + j];
  return s;
}

#define XB_TMO      128
#define XB_XCNT(j)  (256  + 64 * (j))
#define XB_XSUB(j)  (1280 + 64 * (j))
#define XB_XGEN(j)  (2304 + 64 * (j))
#define XB_TOP      3328
#define XB_TOPGEN   3392
#define XCD_BAR_WORDS 3456
#define XB_SPIN_CAP (1u << 22)
#define LAS __attribute__((address_space(3)))
DI unsigned xb_ld(unsigned* p) { return __hip_atomic_load(p, __ATOMIC_RELAXED, __HIP_MEMORY_SCOPE_AGENT); }
DI unsigned xb_add(unsigned* p, unsigned v) { return __hip_atomic_fetch_add(p, v, __ATOMIC_RELAXED, __HIP_MEMORY_SCOPE_AGENT); }
DI unsigned xb_xcc_id() { return (unsigned)__builtin_amdgcn_s_getreg((3 << 11) | 20) & 0xFu; }
#define XB_SPIN(cond, bar) do { unsigned _sp = 0; while (cond) { __builtin_amdgcn_s_sleep(1); \
    if ((++_sp & 255u) == 0u) { if (xb_ld(&(bar)[XB_TMO])) break; if (_sp > XB_SPIN_CAP) { atomicAdd(&(bar)[XB_TMO], 1u); break; } } } } while (0)
struct XcdBarrier { unsigned* bar; unsigned x; volatile LAS unsigned* st; };
DI XcdBarrier xcd_barrier_post(unsigned* bar, volatile LAS unsigned* st) {
  XcdBarrier b; b.bar = bar; b.x = xb_xcc_id(); b.st = st;
  if (threadIdx.x == 0) (void)xb_add(&bar[XB_XCNT(b.x)], 1u);
  return b;
}
DI void xcd_barrier_complete(unsigned* bar, unsigned x, unsigned& nloc, unsigned& nx) {
  const unsigned G = gridDim.x * gridDim.y * gridDim.z;
  unsigned sum, cnt, mine, sp = 0u;
  for (;;) {
    sum = 0u; cnt = 0u; mine = 0u;
#pragma unroll
    for (unsigned j = 0; j < 16; ++j) { const unsigned c = xb_ld(&bar[XB_XCNT(j)]); sum += c; cnt += (c > 0u) ? 1u : 0u; mine = (j == x) ? c : mine; }
    if (sum == G) break;
    __builtin_amdgcn_s_sleep(1);
    if ((++sp & 255u) == 0u) { if (xb_ld(&bar[XB_TMO])) break; if (sp > XB_SPIN_CAP) { atomicAdd(&bar[XB_TMO], 1u); break; } }
  }
  nloc = mine > 0u ? mine : 1u; nx = cnt > 0u ? cnt : 1u;
}
DI void xcd_barrier(const XcdBarrier& b) {
  asm volatile("s_waitcnt vmcnt(0)" ::: "memory");
  __syncthreads();
  if (threadIdx.x == 0) {
    unsigned* bar = b.bar;
    __builtin_amdgcn_s_waitcnt(0);
    unsigned nloc = b.st[0], nx = b.st[1];
    if (nloc == 0u) { xcd_barrier_complete(bar, b.x, nloc, nx); b.st[0] = nloc; b.st[1] = nx; }
    const unsigned old = xb_add(&bar[XB_XSUB(b.x)], 1u);
    const unsigned gen = old / nloc;
    if (old + 1u == (gen + 1u) * nloc) {
      __builtin_amdgcn_fence(__ATOMIC_RELEASE, "agent");
      asm volatile("s_waitcnt vmcnt(0)" ::: "memory");
      const unsigned og = xb_add(&bar[XB_TOP], 1u);
      const unsigned tg = og / nx;
      if (og + 1u == (tg + 1u) * nx) xb_add(&bar[XB_TOPGEN], 1u);
      else XB_SPIN(xb_ld(&bar[XB_TOPGEN]) == tg, bar);
      __builtin_amdgcn_fence(__ATOMIC_ACQUIRE, "agent");
      xb_add(&bar[XB_XGEN(b.x)], 1u);
      asm volatile("s_waitcnt vmcnt(0)" ::: "memory");
    } else {
      XB_SPIN(xb_ld(&bar[XB_XGEN(b.x)]) == gen, bar);
      __builtin_amdgcn_fence(__ATOMIC_ACQUIRE, "agent");
      asm volatile("s_waitcnt vmcnt(0)" ::: "memory");
    }
  }
  __syncthreads();
}

DI void p0_mod_item(const Params& p, int item, unsigned char* smem) {
  const int kq = item & 7, cc = (item >> 3) % 24, layer = item / 192;
  float* sSil = (float*)smem;
  float* sRed = sSil + 9 * 128;
  const int tid = threadIdx.x;
  __syncthreads();
#pragma unroll
  for (int ii = 0; ii < 5; ++ii) {
    const int i = tid + 256 * ii;
    if (i < 9 * 128) {
      const int cnd = i >> 7, k = i & 127;
      const float v = (cnd == 0) ? p.in[6][kq * 128 + k] : p.in[5][(cnd - 1) * 1024 + kq * 128 + k];
      sSil[i] = siluf(v);
    }
  }
  const int c4 = tid & 31, kg = tid >> 5;
  const float* W = p.in[7] + (size_t)layer * 1024 * 3072 + (size_t)(kq * 128) * 3072 + cc * 128 + c4 * 4;
  f32x4 w[16];
#pragma unroll
  for (int i = 0; i < 16; ++i) w[i] = *(const f32x4*)(W + (size_t)(kg + 8 * i) * 3072);
  __syncthreads();
  float acc[9][4];
#pragma unroll
  for (int c = 0; c < 9; ++c) { acc[c][0] = acc[c][1] = acc[c][2] = acc[c][3] = 0.f; }
#pragma unroll
  for (int i = 0; i < 16; ++i) {
    const int kk = kg + 8 * i;
#pragma unroll
    for (int c = 0; c < 9; ++c) {
      const float s = sSil[c * 128 + kk];
      acc[c][0] += s * w[i].x; acc[c][1] += s * w[i].y; acc[c][2] += s * w[i].z; acc[c][3] += s * w[i].w;
    }
  }
#pragma unroll
  for (int c = 0; c < 9; ++c)
#pragma unroll
    for (int j = 0; j < 4; ++j) sRed[(kg * 9 + c) * 128 + c4 * 4 + j] = acc[c][j];
  __syncthreads();
  float* modp = (float*)(p.ws + WS_MODP);
  for (int i = tid; i < 9 * 128; i += NTHR) {
    int cnd = i >> 7, col = i & 127;
    float s = 0.f;
#pragma unroll
    for (int g = 0; g < 8; ++g) s += sRed[(g * 9 + cnd) * 128 + col];
    if (kq == 0) s += p.in[8][layer * 3072 + cc * 128 + col];
    modp[((size_t)((kq * 2 + layer) * 9 + cnd)) * 3072 + cc * 128 + col] = s;
  }
}

DI void p0_tr_item(const float* W, int K, int N, int ntn, bf16_t* Wt, int tile, unsigned char* smem) {
  float* sT = (float*)smem;
  const int tid = threadIdx.x;
  const int kt = tile / ntn, nt = tile % ntn, k0 = kt * 64, n0 = nt * 64;
  __syncthreads();
#pragma unroll
  for (int i = 0; i < 4; ++i) {
    const int r = (tid >> 4) + 16 * i, c4 = (tid & 15) * 4, n = n0 + c4;
    f32x4 v = {0.f, 0.f, 0.f, 0.f};
    if (n < N) v = *(const f32x4*)(W + (size_t)(k0 + r) * N + n);
    sT[r * 65 + c4 + 0] = v.x; sT[r * 65 + c4 + 1] = v.y; sT[r * 65 + c4 + 2] = v.z; sT[r * 65 + c4 + 3] = v.w;
  }
  __syncthreads();
  const int n = tid >> 2, kc = (tid & 3) * 16;
  u32x4 o0, o1;
  o0.x = pk2(sT[(kc + 0) * 65 + n], sT[(kc + 1) * 65 + n]);   o0.y = pk2(sT[(kc + 2) * 65 + n], sT[(kc + 3) * 65 + n]);
  o0.z = pk2(sT[(kc + 4) * 65 + n], sT[(kc + 5) * 65 + n]);   o0.w = pk2(sT[(kc + 6) * 65 + n], sT[(kc + 7) * 65 + n]);
  o1.x = pk2(sT[(kc + 8) * 65 + n], sT[(kc + 9) * 65 + n]);   o1.y = pk2(sT[(kc + 10) * 65 + n], sT[(kc + 11) * 65 + n]);
  o1.z = pk2(sT[(kc + 12) * 65 + n], sT[(kc + 13) * 65 + n]); o1.w = pk2(sT[(kc + 14) * 65 + n], sT[(kc + 15) * 65 + n]);
  bf16_t* dst = Wt + (size_t)(n0 + n) * K + k0 + kc;
  *(u32x4*)dst = o0;
  *(u32x4*)(dst + 8) = o1;
}

constexpr int P0_MOD = 384, P0_TR = 976, P0_CACHE = 320, P0_ROPE = 16;
constexpr int P0_ITEMS = P0_MOD + P0_TR + P0_CACHE + P0_ROPE;

DI void phase0(const Params& p, unsigned char* smem) {
  const int tid = threadIdx.x;
  for (int it = blockIdx.x; it < P0_ITEMS; it += gridDim.x) {
    int r = it;
    if (r < P0_MOD) { p0_mod_item(p, r, smem); continue; }
    r -= P0_MOD;
    if (r < P0_TR) {
      if (r < 640) { p0_tr_item(p.in[11], 1024, 2464, 40, (bf16_t*)(p.ws + WS_WT_AIN), r, smem); continue; } r -= 640;
      if (r < 48)  { p0_tr_item(p.in[14], 256, 768, 12, (bf16_t*)(p.ws + WS_WT_UQ), r, smem); continue; } r -= 48;
      if (r < 16)  { p0_tr_item(p.in[15], 128, 512, 8, (bf16_t*)(p.ws + WS_WT_UKV), r, smem); continue; } r -= 16;
      if (r < 16)  { p0_tr_item(p.in[16], 128, 512, 8, (bf16_t*)(p.ws + WS_WT_UKV) + 512 * 128, r, smem); continue; } r -= 16;
      if (r < 256) { p0_tr_item(p.in[21], 1024, 1024, 16, (bf16_t*)(p.ws + WS_WT_AOUT), r, smem); continue; } r -= 256;
      continue;
    }
    r -= P0_TR;
    if (r < P0_CACHE) {
      if (r < 256) {
        const int idx = r * 2048 + tid * 8;
        const int b = idx >> 16, rem = idx & 65535;
        const f32x4 v0 = *(const f32x4*)(p.in[2] + idx), v1 = *(const f32x4*)(p.in[2] + idx + 4);
        u32x4 o; o.x = pk2(v0.x, v0.y); o.y = pk2(v0.z, v0.w); o.z = pk2(v1.x, v1.y); o.w = pk2(v1.z, v1.w);
        *(u32x4*)((bf16_t*)(p.ws + WS_CKV) + (size_t)(4096 + b * 1536) * 128 + rem) = o;
      } else {
        const int idx = (r - 256) * 2048 + tid * 8;
        const int b = idx >> 14, rem = idx & 16383;
        const f32x4 v0 = *(const f32x4*)(p.in[3] + idx), v1 = *(const f32x4*)(p.in[3] + idx + 4);
        u32x4 o; o.x = pk2(v0.x, v0.y); o.y = pk2(v0.z, v0.w); o.z = pk2(v1.x, v1.y); o.w = pk2(v1.z, v1.w);
        *(u32x4*)((bf16_t*)(p.ws + WS_KR) + (size_t)(4096 + b * 1536) * 32 + rem) = o;
      }
      continue;
    }
    r -= P0_CACHE;
    {
      float* rope = (float*)(p.ws + WS_ROPE);
#pragma unroll
      for (int e = 0; e < 4; ++e) {
        const int idx = r * 1024 + tid * 4 + e;
        const int pos = idx >> 4, i = idx & 15;
        const float coord = (float)((i < 8) ? (pos >> 6) : (pos & 63));
        const float inv = powf(10000.f, -(float)(i & 7) / 8.f);
        const float ang = coord * inv;
        float sn, cs; sincosf(ang, &sn, &cs);
        rope[idx * 2] = cs; rope[idx * 2 + 1] = sn;
      }
    }
  }
}

DI void convert_c_weights(const Params& p, int w, int nw, unsigned char* smem) {
  for (int r = w; r < 1824; r += nw) {
    if (r < 1312) p0_tr_item(p.in[22], 1024, 5184, 82, (bf16_t*)(p.ws + WS_WT_CIN), r, smem);
    else p0_tr_item(p.in[29], 2048, 1024, 16, (bf16_t*)(p.ws + WS_WT_COUT), r - 1312, smem);
  }
}

DI void phase_h(const Params& p, int layer, const float* xA  , const float* xB  ,
                const bf16_t* xbf  , bf16_t* H, unsigned char* smem) {
  float* sA = (float*)smem;
  float* sB = sA + 1024;
  const int tid = threadIdx.x, lane = tid & 63, wave = tid >> 6;
  const float* modp = (const float*)(p.ws + WS_MODP);
  const float* g = p.in[9] + layer * 1024;
  for (int unit = blockIdx.x; unit < T_ALL / 16; unit += gridDim.x) {
    const int row0 = unit * 16;
    const int cond = cond_of_row(row0);
    __syncthreads();
    {
      const int j = tid * 4;
      f32x4 sh = {0.f, 0.f, 0.f, 0.f}, sc = {0.f, 0.f, 0.f, 0.f};
#pragma unroll
      for (int kq = 0; kq < 8; ++kq) {
        const float* mp = modp + ((size_t)((kq * 2 + layer) * 9 + cond)) * 3072 + j;
        sh += *(const f32x4*)mp;
        sc += *(const f32x4*)(mp + 1024);
      }
      const f32x4 gg = *(const f32x4*)(g + j);
      f32x4 a = {gg.x * (1.f + sc.x), gg.y * (1.f + sc.y), gg.z * (1.f + sc.z), gg.w * (1.f + sc.w)};
      *(f32x4*)(sA + j) = a;
      *(f32x4*)(sB + j) = sh;
    }
    __syncthreads();
#pragma unroll
    for (int i = 0; i < 4; ++i) {
      const int row = row0 + wave * 4 + i;
      f32x4 v[4]; float ss = 0.f;
      if (xbf != nullptr) {
#pragma unroll
        for (int jj = 0; jj < 2; ++jj) {
          const u32x4 xw = *(const u32x4*)(xbf + (size_t)row * 1024 + lane * 8 + 512 * jj);
          v[2 * jj].x = bflo(xw.x); v[2 * jj].y = bfhi(xw.x); v[2 * jj].z = bflo(xw.y); v[2 * jj].w = bfhi(xw.y);
          v[2 * jj + 1].x = bflo(xw.z); v[2 * jj + 1].y = bfhi(xw.z); v[2 * jj + 1].z = bflo(xw.w); v[2 * jj + 1].w = bfhi(xw.w);
        }
      } else {
        const float* xr = (row < T_P) ? (xA + (size_t)row * 1024) : (xB + (size_t)(row - T_P) * 1024);
#pragma unroll
        for (int j = 0; j < 4; ++j) v[j] = *(const f32x4*)(xr + lane * 8 + 512 * (j >> 1) + 4 * (j & 1));
      }
#pragma unroll
      for (int j = 0; j < 4; ++j) ss += v[j].x * v[j].x + v[j].y * v[j].y + v[j].z * v[j].z + v[j].w * v[j].w;
      ss = wave_sum(ss);
      const float rstd = rsqrtf(ss * (1.f / 1024.f) + 1e-6f);
#pragma unroll
      for (int jj = 0; jj < 2; ++jj) {
        const int c = lane * 8 + 512 * jj;
        const f32x4 a0 = *(const f32x4*)(sA + c), b0 = *(const f32x4*)(sB + c), a1 = *(const f32x4*)(sA + c + 4), b1 = *(const f32x4*)(sB + c + 4);
        const f32x4 x0 = v[2 * jj], x1 = v[2 * jj + 1];
        u32x4 o;
        o.x = pk2(x0.x * rstd * a0.x + b0.x, x0.y * rstd * a0.y + b0.y);
        o.y = pk2(x0.z * rstd * a0.z + b0.z, x0.w * rstd * a0.w + b0.w);
        o.z = pk2(x1.x * rstd * a1.x + b1.x, x1.y * rstd * a1.y + b1.y);
        o.w = pk2(x1.z * rstd * a1.z + b1.z, x1.w * rstd * a1.w + b1.w);
        *(u32x4*)(H + (size_t)row * 1024 + c) = o;
      }
    }
  }
}

template <class Epi, int MODE = 0, bool IL = false, int KH = 1>
DI void gemm_tile(const bf16_t* __restrict__ A, int lda, const bf16_t* __restrict__ Bt, int ldb, int K,
                  int m0, int n0, unsigned char* smem, Epi& epi) {
  bf16_t* sA = (bf16_t*)smem;
  bf16_t* sB = sA + 128 * 64;
  const int tid = threadIdx.x, lane = tid & 63, wave = tid >> 6, wm = wave >> 1, wn = wave & 1, l31 = lane & 31, hf = lane >> 5;
  const int lr = tid >> 3, lc = (tid & 7) * 8;
  const bf16_t* ga = A + (size_t)(m0 + lr) * lda + lc;
  const bf16_t* gb = Bt + (size_t)(n0 + lr) * ldb + lc;
  u32x4 ra0[4], rb0[4], ra1[4], rb1[4];
  f32x16 acc[2][2];
#pragma unroll
  for (int i = 0; i < 2; ++i)
#pragma unroll
    for (int j = 0; j < 2; ++j)
#pragma unroll
      for (int r = 0; r < 16; ++r) acc[i][j][r] = 0.f;
  const int nk = K >> 6;
  constexpr int BUFE = 2 * 128 * 64;
  const int wofs = lr * 64 + (((tid & 7) ^ ((lr >> 1) & 7)) << 3);
  const int rsw = (l31 >> 1) & 7;
  const int rofA = (wm * 64 + l31) * 64, rofB = (wn * 64 + l31) * 64;
#define G_LOAD(RA, RB, KT) _Pragma("unroll") for (int i = 0; i < 4; ++i) { RA[i] = *(const u32x4*)(ga + (size_t)(32 * i) * lda + (KT) * 64); RB[i] = *(const u32x4*)(gb + (size_t)(32 * i) * ldb + (KT) * 64); }
#define G_STORE(RA, RB, SLOT) { bf16_t* nA = sA + (SLOT) * BUFE; bf16_t* nB = sB + (SLOT) * BUFE; _Pragma("unroll") for (int i = 0; i < 4; ++i) { *(u32x4*)(nA + wofs + 32 * 64 * i) = RA[i]; *(u32x4*)(nB + wofs + 32 * 64 * i) = RB[i]; } }
#define G_COMPUTE(SLOT) { const bf16_t* cA = sA + (SLOT) * BUFE; const bf16_t* cB = sB + (SLOT) * BUFE; _Pragma("unroll") for (int ks = 0; ks < 4; ++ks) { \
      const int co = (((ks * 2 + hf) ^ rsw) << 3); \
      const bf16x8 a0 = *(const bf16x8*)(cA + rofA + co); \
      const bf16x8 a1 = *(const bf16x8*)(cA + rofA + 32 * 64 + co); \
      const bf16x8 b0 = *(const bf16x8*)(cB + rofB + co); \
      const bf16x8 b1 = *(const bf16x8*)(cB + rofB + 32 * 64 + co); \
      __builtin_amdgcn_s_setprio(1); \
      acc[0][0] = MFMA32(b0, a0, acc[0][0]); acc[0][1] = MFMA32(b1, a0, acc[0][1]); \
      acc[1][0] = MFMA32(b0, a1, acc[1][0]); acc[1][1] = MFMA32(b1, a1, acc[1][1]); \
      __builtin_amdgcn_s_setprio(0); } }
#pragma unroll 1
  for (int kh = 0; kh < KH; ++kh) {
  G_LOAD(ra0, rb0, 0)
  __syncthreads();
  G_STORE(ra0, rb0, 0)
  G_LOAD(ra0, rb0, 1)
  if (nk > 2) G_LOAD(ra1, rb1, 2)
#define G_STEP(CSLOT, SSLOT, RA, RB, DO_STORE, DO_LOAD, LKT) { \
    const bf16_t* cA = sA + (CSLOT) * BUFE; const bf16_t* cB = sB + (CSLOT) * BUFE; \
    bf16_t* nA = sA + (SSLOT) * BUFE; bf16_t* nB = sB + (SSLOT) * BUFE; \
    _Pragma("unroll") for (int ks = 0; ks < 4; ++ks) { \
      const int co = (((ks * 2 + hf) ^ rsw) << 3); \
      const bf16x8 a0 = *(const bf16x8*)(cA + rofA + co); \
      const bf16x8 a1 = *(const bf16x8*)(cA + rofA + 32 * 64 + co); \
      const bf16x8 b0 = *(const bf16x8*)(cB + rofB + co); \
      const bf16x8 b1 = *(const bf16x8*)(cB + rofB + 32 * 64 + co); \
      acc[0][0] = MFMA32(b0, a0, acc[0][0]); \
      if (DO_STORE) *(u32x4*)(nA + wofs + 32 * 64 * ks) = RA[ks]; \
      acc[0][1] = MFMA32(b1, a0, acc[0][1]); \
      if (DO_LOAD) RA[ks] = *(const u32x4*)(ga + (size_t)(32 * ks) * lda + (LKT) * 64); \
      acc[1][0] = MFMA32(b0, a1, acc[1][0]); \
      if (DO_STORE) *(u32x4*)(nB + wofs + 32 * 64 * ks) = RB[ks]; \
      acc[1][1] = MFMA32(b1, a1, acc[1][1]); \
      if (DO_LOAD) RB[ks] = *(const u32x4*)(gb + (size_t)(32 * ks) * ldb + (LKT) * 64); \
    } }
  if (IL) {
  for (int kt = 0; kt < nk; kt += 2) {
    __syncthreads();
    if (kt + 3 < nk) G_STEP(0, 1, ra0, rb0, true, true, kt + 3)
    else G_STEP(0, 1, ra0, rb0, true, false, 0)
    __syncthreads();
    if (kt + 4 < nk) G_STEP(1, 0, ra1, rb1, true, true, kt + 4)
    else if (kt + 2 < nk) G_STEP(1, 0, ra1, rb1, true, false, 0)
    else G_STEP(1, 0, ra1, rb1, false, false, 0)
  }
  } else {
  for (int kt = 0; kt < nk; kt += 2) {
    __syncthreads();
    G_STORE(ra0, rb0, 1)
    if (kt + 3 < nk) G_LOAD(ra0, rb0, kt + 3)
    G_COMPUTE(0)
    __syncthreads();
    if (kt + 2 < nk) {
      G_STORE(ra1, rb1, 0)
      if (kt + 4 < nk) G_LOAD(ra1, rb1, kt + 4)
    }
    G_COMPUTE(1)
  }
  }
  ga += K; gb += K;
  }
#undef G_STEP
#undef G_LOAD
#undef G_STORE
#undef G_COMPUTE
  __syncthreads();
  float* sT = (float*)smem + wave * (64 * 68);
#pragma unroll
  for (int i = 0; i < 2; ++i)
#pragma unroll
    for (int j = 0; j < 2; ++j)
#pragma unroll
      for (int q = 0; q < 4; ++q) {
        f32x4 v = {acc[i][j][4 * q], acc[i][j][4 * q + 1], acc[i][j][4 * q + 2], acc[i][j][4 * q + 3]};
        *(f32x4*)(sT + (i * 32 + l31) * 68 + j * 32 + 8 * q + 4 * hf) = v;
      }
  epi.wave_tile(sT, m0 + wm * 64, n0 + wn * 64, lane);
}

template <int NIT = 16, class F>
DI void tile_rowwise(const float* sT, int lane, F f) {
#pragma unroll 2
  for (int it = 0; it < NIT; ++it) {
    const int row = (lane >> 4) + 4 * it, col = (lane & 15) * 4;
    const f32x4 v = *(const f32x4*)(sT + row * 68 + col);
    f(row, col, v);
  }
}

template <int NIT = 16, class F>
DI void tile_rowwise8(const float* sT, int lane, F f) {
#pragma unroll 2
  for (int it = 0; it < NIT / 2; ++it) {
    const int row = (lane >> 3) + 8 * it, col = (lane & 7) * 8;
    const f32x4 v0 = *(const f32x4*)(sT + row * 68 + col), v1 = *(const f32x4*)(sT + row * 68 + col + 4);
    u32x4 o; o.x = pk2(v0.x, v0.y); o.y = pk2(v0.z, v0.w); o.z = pk2(v1.x, v1.y); o.w = pk2(v1.z, v1.w);
    f(row, col, o);
  }
}

template <int NIT = 16, class F>
DI void tile_rowwise8f(const float* sT, int lane, F f) {
#pragma unroll 2
  for (int it = 0; it < NIT / 2; ++it) {
    const int row = (lane >> 3) + 8 * it, col = (lane & 7) * 8;
    const f32x4 v0 = *(const f32x4*)(sT + row * 68 + col), v1 = *(const f32x4*)(sT + row * 68 + col + 4);
    f(row, col, v0, v1);
  }
}

struct EpiAin {
  bf16_t* UA;
  DI void prep(int, int, unsigned char*) {}
  template <int NIT = 16>
  DI void wave_tile(const float* sT, int mr, int nc, int lane) {
    bf16_t* ua = UA;
    tile_rowwise8f<NIT>(sT, lane, [=](int row, int col, f32x4 v, f32x4 w) {
      const int gcol = nc + col;
      if (gcol < 2464) {
        if (gcol >= 1440) {
          v.x = siluf(v.x); v.y = siluf(v.y); v.z = siluf(v.z); v.w = siluf(v.w);
          w.x = siluf(w.x); w.y = siluf(w.y); w.z = siluf(w.z); w.w = siluf(w.w);
        } else if (gcol >= 928) {
          v.x = sigmoidf_(v.x); v.y = sigmoidf_(v.y); v.z = sigmoidf_(v.z); v.w = sigmoidf_(v.w);
          w.x = sigmoidf_(w.x); w.y = sigmoidf_(w.y); w.z = sigmoidf_(w.z); w.w = sigmoidf_(w.w);
        }
        u32x4 o; o.x = pk2(v.x, v.y); o.y = pk2(v.z, v.w); o.z = pk2(w.x, w.y); o.w = pk2(w.z, w.w);
        *(u32x4*)(ua + (size_t)(mr + row) * 2464 + gcol) = o;
      }
    });
  }
};
struct EpiQ {
  DI void after_tile(int, unsigned char*) {}
  bf16_t* Q; const float* rope;
  DI void prep(int, int, unsigned char*) {}
  DI void wave_tile(const float* sT, int mr, int nc, int lane) {
    bf16_t* q = Q; const float* rp = rope;
    tile_rowwise8f(sT, lane, [=](int row, int col, f32x4 v, f32x4 w) {
      const int grow = mr + row, gcol = nc + col;
      const int c96 = gcol % 96;
      if (grow >= T_P && c96 >= 64) {
        const int pos = (grow - T_P) & 1023, ip = (c96 - 64) >> 1;
        const f32x4 cs = *(const f32x4*)(rp + (pos * 16 + ip) * 2);
        const f32x4 cs2 = *(const f32x4*)(rp + (pos * 16 + ip + 2) * 2);
        const float a0 = v.x * cs.x - v.y * cs.y, b0 = v.x * cs.y + v.y * cs.x;
        const float a1 = v.z * cs.z - v.w * cs.w, b1 = v.z * cs.w + v.w * cs.z;
        const float a2 = w.x * cs2.x - w.y * cs2.y, b2 = w.x * cs2.y + w.y * cs2.x;
        const float a3 = w.z * cs2.z - w.w * cs2.w, b3 = w.z * cs2.w + w.w * cs2.z;
        v.x = a0; v.y = b0; v.z = a1; v.w = b1; w.x = a2; w.y = b2; w.z = a3; w.w = b3;
      }
      u32x4 o; o.x = pk2(v.x, v.y); o.y = pk2(v.z, v.w); o.z = pk2(w.x, w.y); o.w = pk2(w.z, w.w);
      *(u32x4*)(q + (size_t)grow * 768 + gcol) = o;
    });
  }
};
struct EpiKV {
  DI void after_tile(int, unsigned char*) {}
  bf16_t* KN; bf16_t* VTP; bf16_t* VTS;
  DI void prep(int, int, unsigned char*) {}
  DI void wave_tile(const float* sT, int mr, int nc, int lane) {
    if (nc < 512) {
      bf16_t* kn = KN;
      tile_rowwise8(sT, lane, [=](int row, int col, u32x4 o) {
        *(u32x4*)(kn + (size_t)(mr + row) * 512 + nc + col) = o;
      });
    } else {
      const int hh = (nc - 512) >> 6;
      bf16_t* base; int Lk, key0;
      if (mr < T_P) { const int b = mr >> 8; key0 = mr & 255; Lk = 256; base = VTP + (size_t)(b * 8 + hh) * 64 * 256; }
      else { const int r2 = mr - T_P, b = r2 / 1536; key0 = r2 - b * 1536; Lk = 1536; base = VTS + (size_t)(b * 8 + hh) * 64 * 1536; }
#pragma unroll 2
      for (int it = 0; it < 8; ++it) {
        const int d = (lane >> 3) + 8 * it, k8 = (lane & 7) * 8;
        const float* sp = sT + k8 * 68 + d;
        u32x4 o;
        o.x = pk2(sp[0], sp[68]); o.y = pk2(sp[2 * 68], sp[3 * 68]); o.z = pk2(sp[4 * 68], sp[5 * 68]); o.w = pk2(sp[6 * 68], sp[7 * 68]);
        *(u32x4*)(base + (size_t)d * Lk + key0 + k8) = o;
      }
    }
  }
};
struct EpiRes {
  const float* modp; int layer; const float* xA; const float* xB; const bf16_t* xin; bf16_t* outb; float* sGate; int gate_n0;
  DI void prep(int m0, int n0, unsigned char* smem) {
    sGate = (float*)(smem + 2 * 36864);
    const int cond = cond_of_row(m0);
    __syncthreads();
    if (threadIdx.x < 128) sGate[threadIdx.x] = modp_sum(modp, layer, cond, 2048 + n0 + threadIdx.x);
    gate_n0 = n0;
  }
  template <int NIT = 16>
  DI void wave_tile(const float* sT, int mr, int nc, int lane) {
    const float* xa = xA; const float* xb = xB; const bf16_t* xi = xin; bf16_t* o = outb; const float* sg = sGate + (nc - gate_n0);
    tile_rowwise8f<NIT>(sT, lane, [=](int row, int col, f32x4 v, f32x4 w) {
      const int grow = mr + row, gcol = nc + col;
      const f32x4 g0 = *(const f32x4*)(sg + col), g1 = *(const f32x4*)(sg + col + 4);
      f32x4 x0, x1;
      if (xi != nullptr) {
        const u32x4 xw = *(const u32x4*)(xi + (size_t)grow * 1024 + gcol);
        x0.x = bflo(xw.x); x0.y = bfhi(xw.x); x0.z = bflo(xw.y); x0.w = bfhi(xw.y);
        x1.x = bflo(xw.z); x1.y = bfhi(xw.z); x1.z = bflo(xw.w); x1.w = bfhi(xw.w);
      } else {
        const float* xp = (grow < T_P) ? (xa + (size_t)grow * 1024 + gcol) : (xb + (size_t)(grow - T_P) * 1024 + gcol);
        x0 = *(const f32x4*)xp; x1 = *(const f32x4*)(xp + 4);
      }
      u32x4 r;
      r.x = pk2(x0.x + g0.x * v.x, x0.y + g0.y * v.y); r.y = pk2(x0.z + g0.z * v.z, x0.w + g0.w * v.w);
      r.z = pk2(x1.x + g1.x * w.x, x1.y + g1.y * w.y); r.w = pk2(x1.z + g1.z * w.z, x1.w + g1.w * w.w);
      *(u32x4*)(o + (size_t)grow * 1024 + gcol) = r;
    });
  }
};
struct EpiCin {
  bf16_t* Z; bf16_t* RAWB; bf16_t* XC; float* DT; const float* dtb; const float* cw; const float* cb;
  DI void prep(int, int, unsigned char*) {}
  template <int NIT = 16>
  DI void wave_tile(const float* sT, int mr, int nc, int lane) {
    if (nc < 2048) {
      bf16_t* z = Z;
      tile_rowwise8<NIT>(sT, lane, [=](int row, int col, u32x4 o) {
        *(u32x4*)(z + (size_t)(mr + row) * 2048 + nc + col) = o;
      });
    } else if (nc < 5120) {
      const int cbase = nc - 2048, col = (lane & 7) * 8, rg = lane >> 3;
      float w[5][8], bias[8];
#pragma unroll
      for (int k = 0; k < 5; ++k) {
        const f32x4 a = *(const f32x4*)(cw + k * 3072 + cbase + col), b4 = *(const f32x4*)(cw + k * 3072 + cbase + col + 4);
        w[k][0] = a.x; w[k][1] = a.y; w[k][2] = a.z; w[k][3] = a.w; w[k][4] = b4.x; w[k][5] = b4.y; w[k][6] = b4.z; w[k][7] = b4.w;
      }
      {
        const f32x4 a = *(const f32x4*)(cb + cbase + col), b4 = *(const f32x4*)(cb + cbase + col + 4);
        bias[0] = a.x; bias[1] = a.y; bias[2] = a.z; bias[3] = a.w; bias[4] = b4.x; bias[5] = b4.y; bias[6] = b4.z; bias[7] = b4.w;
      }
      f32x4 win0[5], win1[5];
#pragma unroll
      for (int j = 0; j < 12; ++j) {
        const int r = rg * 8 - 2 + j;
        f32x4 v0 = {0.f, 0.f, 0.f, 0.f}, v1 = {0.f, 0.f, 0.f, 0.f};
        if (r >= 0 && r < 64) { v0 = *(const f32x4*)(sT + r * 68 + col); v1 = *(const f32x4*)(sT + r * 68 + col + 4); }
        win0[j % 5] = v0; win1[j % 5] = v1;
        if (j >= 2 && j < 10 && (r < 4 || r >= 60)) {
          const int rb = (r < 4) ? r : r - 56;
          u32x4 o; o.x = pk2(v0.x, v0.y); o.y = pk2(v0.z, v0.w); o.z = pk2(v1.x, v1.y); o.w = pk2(v1.z, v1.w);
          *(u32x4*)(RAWB + ((size_t)((mr >> 6) * 8 + rb)) * 3072 + cbase + col) = o;
        }
        if (j >= 4) {
          const int t = j - 4, ro = rg * 8 + t;
          if (ro >= 2 && ro <= 61) {
            float a[8];
#pragma unroll
            for (int e = 0; e < 8; ++e) a[e] = bias[e];
#pragma unroll
            for (int k = 0; k < 5; ++k) {
              const f32x4 x0 = win0[(t + k) % 5], x1 = win1[(t + k) % 5];
              a[0] += x0.x * w[k][0]; a[1] += x0.y * w[k][1]; a[2] += x0.z * w[k][2]; a[3] += x0.w * w[k][3];
              a[4] += x1.x * w[k][4]; a[5] += x1.y * w[k][5]; a[6] += x1.z * w[k][6]; a[7] += x1.w * w[k][7];
            }
            u32x4 o;
            o.x = pk2(siluf(a[0]), siluf(a[1])); o.y = pk2(siluf(a[2]), siluf(a[3]));
            o.z = pk2(siluf(a[4]), siluf(a[5])); o.w = pk2(siluf(a[6]), siluf(a[7]));
            *(u32x4*)(XC + (size_t)(mr + ro) * 3072 + cbase + col) = o;
          }
        }
      }
    } else if (nc < 5184) {
      float* dt = DT; const float* b = dtb;
      tile_rowwise<NIT>(sT, lane, [=](int row, int col, f32x4 v) {
        const int c = nc - 5120 + col;
        const f32x4 bias = *(const f32x4*)(b + c);
        f32x4 r;
        { const float x = v.x + bias.x; r.x = fmaxf(x, 0.f) + log1pf(__expf(-fabsf(x))); }
        { const float x = v.y + bias.y; r.y = fmaxf(x, 0.f) + log1pf(__expf(-fabsf(x))); }
        { const float x = v.z + bias.z; r.z = fmaxf(x, 0.f) + log1pf(__expf(-fabsf(x))); }
        { const float x = v.w + bias.w; r.w = fmaxf(x, 0.f) + log1pf(__expf(-fabsf(x))); }
        *(f32x4*)(dt + (size_t)(mr + row) * 64 + c) = r;
      });
    }
  }
};

template <bool IL = false, int KH = 1, class Epi>
DI void gemm_phase(const bf16_t* A, int lda, const bf16_t* Bt, int ldb, int K, int mtiles, int ntiles, unsigned char* smem, Epi& epi) {
  if ((gridDim.x & 7) == 0 && (mtiles & 7) == 0) {
    const int xcd = blockIdx.x & 7, j = blockIdx.x >> 3, nb = gridDim.x >> 3, mper = mtiles >> 3;
    for (int idx = j; idx < mper * ntiles; idx += nb) {
      const int nt = idx / mper, mt = xcd * mper + (idx - nt * mper);
      epi.prep(mt * 128, nt * 128, smem);
      gemm_tile<Epi, 0, IL, KH>(A, lda, Bt, ldb, K, mt * 128, nt * 128, smem, epi);
    }
  } else {
    for (int t = blockIdx.x; t < mtiles * ntiles; t += gridDim.x) {
      const int mt = t / ntiles, nt = t - mt * ntiles;
      epi.prep(mt * 128, nt * 128, smem);
      gemm_tile<Epi, 0, IL, KH>(A, lda, Bt, ldb, K, mt * 128, nt * 128, smem, epi);
    }
  }
}

template <class Epi>
DI void gemm_tile_big(const bf16_t* __restrict__ A, int lda, const bf16_t* __restrict__ Bt, int ldb, int K,
                      int m0, int n0, unsigned char* smem, Epi& epi) {
  bf16_t* sA = (bf16_t*)smem;
  bf16_t* sB = sA + 256 * 32;
  constexpr int BUFE = 384 * 32;
  const int tid = threadIdx.x, lane = tid & 63, wave = tid >> 6, wm = wave >> 1, wn = wave & 1, l31 = lane & 31, hf = lane >> 5;
  const int lr = tid >> 2, lch = tid & 3;
  const bf16_t* ga = A + (size_t)(m0 + lr) * lda + lch * 8;
  const bf16_t* gb = Bt + (size_t)(n0 + lr) * ldb + lch * 8;
  const int wofs = lr * 32 + ((lch ^ ((lr >> 2) & 3)) << 3);
  const int rsw = (l31 >> 2) & 3;
  const int rofA = (wm * 128 + l31) * 32, rofB = (wn * 64 + l31) * 32;
  u32x4 ra0[4], rb0[2], ra1[4], rb1[2];
  f32x16 acc[4][2];
#pragma unroll
  for (int i = 0; i < 4; ++i)
#pragma unroll
    for (int j = 0; j < 2; ++j)
#pragma unroll
      for (int r = 0; r < 16; ++r) acc[i][j][r] = 0.f;
  const int nk = K >> 5;
#define GB_LOAD(RA, RB, KT) { _Pragma("unroll") for (int i = 0; i < 4; ++i) RA[i] = *(const u32x4*)(ga + (size_t)(64 * i) * lda + (KT) * 32); \
                              _Pragma("unroll") for (int i = 0; i < 2; ++i) RB[i] = *(const u32x4*)(gb + (size_t)(64 * i) * ldb + (KT) * 32); }
#define GB_STORE(RA, RB, SLOT) { bf16_t* nA = sA + (SLOT) * BUFE; bf16_t* nB = sB + (SLOT) * BUFE; \
                              _Pragma("unroll") for (int i = 0; i < 4; ++i) *(u32x4*)(nA + wofs + 64 * 32 * i) = RA[i]; \
                              _Pragma("unroll") for (int i = 0; i < 2; ++i) *(u32x4*)(nB + wofs + 64 * 32 * i) = RB[i]; }
#define GB_COMPUTE(SLOT) { const bf16_t* cA = sA + (SLOT) * BUFE; const bf16_t* cB = sB + (SLOT) * BUFE; _Pragma("unroll") for (int ks = 0; ks < 2; ++ks) { \
      const int co = (((ks * 2 + hf) ^ rsw) << 3); \
      bf16x8 af[4], bfr[2]; \
      _Pragma("unroll") for (int i = 0; i < 4; ++i) af[i] = *(const bf16x8*)(cA + rofA + 32 * 32 * i + co); \
      _Pragma("unroll") for (int j = 0; j < 2; ++j) bfr[j] = *(const bf16x8*)(cB + rofB + 32 * 32 * j + co); \
      __builtin_amdgcn_s_setprio(1); \
      _Pragma("unroll") for (int i = 0; i < 4; ++i) { acc[i][0] = MFMA32(bfr[0], af[i], acc[i][0]); acc[i][1] = MFMA32(bfr[1], af[i], acc[i][1]); } \
      __builtin_amdgcn_s_setprio(0); } }
  GB_LOAD(ra0, rb0, 0)
  __syncthreads();
  GB_STORE(ra0, rb0, 0)
  GB_LOAD(ra0, rb0, 1)
  if (nk > 2) GB_LOAD(ra1, rb1, 2)
  for (int kt = 0; kt < nk; kt += 2) {
    __syncthreads();
    GB_STORE(ra0, rb0, 1)
    if (kt + 3 < nk) GB_LOAD(ra0, rb0, kt + 3)
    GB_COMPUTE(0)
    __syncthreads();
    if (kt + 2 < nk) {
      GB_STORE(ra1, rb1, 0)
      if (kt + 4 < nk) GB_LOAD(ra1, rb1, kt + 4)
    }
    GB_COMPUTE(1)
  }
#undef GB_LOAD
#undef GB_STORE
#undef GB_COMPUTE
  __syncthreads();
  float* sT = (float*)smem + wave * (32 * 68);
#pragma unroll
  for (int i = 0; i < 4; ++i) {
#pragma unroll
    for (int j = 0; j < 2; ++j)
#pragma unroll
      for (int q = 0; q < 4; ++q) {
        f32x4 v = {acc[i][j][4 * q], acc[i][j][4 * q + 1], acc[i][j][4 * q + 2], acc[i][j][4 * q + 3]};
        *(f32x4*)(sT + l31 * 68 + j * 32 + 8 * q + 4 * hf) = v;
      }
    epi.template wave_tile<8>(sT, m0 + wm * 128 + i * 32, n0 + wn * 64, lane);
  }
}

template <class Epi>
DI void gemm_phase_big(const bf16_t* A, int lda, const bf16_t* Bt, int ldb, int K, int mtiles, int ntiles, unsigned char* smem, Epi& epi) {
  if ((gridDim.x & 7) == 0 && (mtiles & 7) == 0) {
    const int xcd = blockIdx.x & 7, j = blockIdx.x >> 3, nb = gridDim.x >> 3, mper = mtiles >> 3;
    for (int idx = j; idx < mper * ntiles; idx += nb) {
      const int nt = idx / mper, mt = xcd * mper + (idx - nt * mper);
      epi.prep(mt * 256, nt * 128, smem);
      gemm_tile_big(A, lda, Bt, ldb, K, mt * 256, nt * 128, smem, epi);
    }
  } else {
    for (int t = blockIdx.x; t < mtiles * ntiles; t += gridDim.x) {
      const int mt = t / ntiles, nt = t - mt * ntiles;
      epi.prep(mt * 256, nt * 128, smem);
      gemm_tile_big(A, lda, Bt, ldb, K, mt * 256, nt * 128, smem, epi);
    }
  }
}

DI float reduce16(const float (&v)[16], int lane) {
  const bool b5 = (lane & 32) != 0, b4 = (lane & 16) != 0, b3 = (lane & 8) != 0, b2 = (lane & 4) != 0;
  float a[8], b[4], c[2];
#pragma unroll
  for (int i = 0; i < 8; ++i) { const float send = b5 ? v[i] : v[i + 8], keep = b5 ? v[i + 8] : v[i]; a[i] = keep + __shfl_xor(send, 32); }
#pragma unroll
  for (int i = 0; i < 4; ++i) { const float send = b4 ? a[i] : a[i + 4], keep = b4 ? a[i + 4] : a[i]; b[i] = keep + __shfl_xor(send, 16); }
#pragma unroll
  for (int i = 0; i < 2; ++i) { const float send = b3 ? b[i] : b[i + 2], keep = b3 ? b[i + 2] : b[i]; c[i] = keep + __shfl_xor(send, 8); }
  const float send = b2 ? c[0] : c[1], keep = b2 ? c[1] : c[0];
  float d = keep + __shfl_xor(send, 4);
  d += __shfl_xor(d, 2);
  d += __shfl_xor(d, 1);
  return d;
}

DI void phase3(const Params& p, unsigned char* smem) {
  const int tid = threadIdx.x, lane = tid & 63, wave = tid >> 6;
  const bf16_t* UA = (const bf16_t*)(p.ws + WS_UA);
  bf16_t* QN = (bf16_t*)(p.ws + WS_QN);
  bf16_t* CKV = (bf16_t*)(p.ws + WS_CKV);
  bf16_t* KR = (bf16_t*)(p.ws + WS_KR);
  bf16_t* MIX = (bf16_t*)(p.ws + WS_MIX);
  const float* rope = (const float*)(p.ws + WS_ROPE);
  const float* gq = p.in[12];
  const float* gkv = p.in[13];
  auto proc = [&](int row, u32x2 wq, unsigned wkv, unsigned wkr) {
    {
      const float a = bflo(wq.x), b = bfhi(wq.x), c = bflo(wq.y), d = bfhi(wq.y);
      const float ss = wave_sum(a * a + b * b + c * c + d * d);
      const float rstd = rsqrtf(ss * (1.f / 256.f) + 1e-6f);
      const f32x4 g = *(const f32x4*)(gq + lane * 4);
      u32x2 o; o.x = pk2(a * rstd * g.x, b * rstd * g.y); o.y = pk2(c * rstd * g.z, d * rstd * g.w);
      *(u32x2*)(QN + (size_t)row * 256 + lane * 4) = o;
    }
    int kvrow; int pos = 0;
    if (row < T_P) kvrow = row;
    else { const int r2 = row - T_P; const int b = r2 >> 10; pos = r2 & 1023; kvrow = T_P + b * 1536 + 512 + pos; }
    {
      const float a = bflo(wkv), b = bfhi(wkv);
      const float ss = wave_sum(a * a + b * b);
      const float rstd = rsqrtf(ss * (1.f / 128.f) + 1e-6f);
      const float oa = a * rstd * gkv[lane * 2], ob = b * rstd * gkv[lane * 2 + 1];
      *(unsigned*)(CKV + (size_t)kvrow * 128 + lane * 2) = pk2(oa, ob);
      if (row < T_P) { float* o = p.out + OUT_CKV + (size_t)row * 128 + lane * 2; o[0] = oa; o[1] = ob; }
    }
    if (lane < 16) {
      float a = bflo(wkr), b = bfhi(wkr);
      if (row < T_P) {
        float* o = p.out + OUT_KR + (size_t)row * 32 + lane * 2; o[0] = a; o[1] = b;
      } else {
        const float cs = rope[(pos * 16 + lane) * 2], sn = rope[(pos * 16 + lane) * 2 + 1];
        const float na = a * cs - b * sn, nb = a * sn + b * cs;
        a = na; b = nb;
      }
      *(unsigned*)(KR + (size_t)kvrow * 32 + lane * 2) = pk2(a, b);
    }
  };
  {
    int rbeg = 0, rend = T_ALL, nw = gridDim.x * 4, w0 = blockIdx.x * 4 + wave;
    if (gridDim.x == 512) {
      if (blockIdx.x >= 384) { rbeg = 0; rend = 6400; nw = 128 * 4; w0 = (blockIdx.x - 384) * 4 + wave; }
      else { rbeg = 6400; rend = T_ALL; nw = 384 * 4; }
    }
    for (int row = rbeg + w0; row < rend; row += 2 * nw) {
      const int row2 = row + nw; const bool has2 = row2 < rend;
      const bf16_t* u0 = UA + (size_t)row * 2464;
      const bf16_t* u1 = UA + (size_t)(has2 ? row2 : row) * 2464;
      const u32x2 wq0 = *(const u32x2*)(u0 + lane * 4), wq1 = *(const u32x2*)(u1 + lane * 4);
      const unsigned wkv0 = *(const unsigned*)(u0 + 256 + lane * 2), wkv1 = *(const unsigned*)(u1 + 256 + lane * 2);
      const unsigned wkr0 = *(const unsigned*)(u0 + 384 + (lane & 15) * 2), wkr1 = *(const unsigned*)(u1 + 384 + (lane & 15) * 2);
      proc(row, wq0, wkv0, wkr0);
      if (has2) proc(row2, wq1, wkv1, wkr1);
    }
  }
  bf16_t* sCv = (bf16_t*)smem;
  float* sRed = (float*)(smem + 62 * 512 * 2);
  const float* cw = p.in[17];
  const float* cb = p.in[18];
  const float* lg = p.in[19];
  const float* lb = p.in[20];
  for (int tile = blockIdx.x; tile < T_ALL / 32; tile += gridDim.x) {
    const int t0 = tile * 32;
    int s0, s1;
    if (t0 < T_P) { s0 = t0 & ~255; s1 = s0 + 256; } else { s0 = T_P + ((t0 - T_P) & ~1023); s1 = s0 + 1024; }
    __syncthreads();
#pragma unroll 8
    for (int ch = tid; ch < 62 * 64; ch += NTHR) {
      const int r = ch >> 6, c8 = (ch & 63) * 8;
      const int row = t0 - 15 + r;
      u32x4 o = {0u, 0u, 0u, 0u};
      if (row >= s0 && row < s1) {
        const u32x4 ga = *(const u32x4*)(UA + (size_t)row * 2464 + 416 + c8);
        const u32x4 gb = *(const u32x4*)(UA + (size_t)row * 2464 + 928 + c8);
        o.x = pk2(bflo(ga.x) * bflo(gb.x), bfhi(ga.x) * bfhi(gb.x));
        o.y = pk2(bflo(ga.y) * bflo(gb.y), bfhi(ga.y) * bfhi(gb.y));
        o.z = pk2(bflo(ga.z) * bflo(gb.z), bfhi(ga.z) * bfhi(gb.z));
        o.w = pk2(bflo(ga.w) * bflo(gb.w), bfhi(ga.w) * bfhi(gb.w));
      }
      *(u32x4*)(sCv + r * 512 + c8) = o;
    }
    __syncthreads();
    const int c = tid * 2;
    float wk0[31], wk1[31];
#pragma unroll
    for (int k = 0; k < 31; ++k) { const float2 w = *(const float2*)(cw + k * 512 + c); wk0[k] = w.x; wk1[k] = w.y; }
#pragma unroll 1
    for (int half = 0; half < 2; ++half) {
      const int tb = half * 16;
      float acc0[16], acc1[16];
      {
        const float b0 = cb[c], b1 = cb[c + 1];
#pragma unroll
        for (int t = 0; t < 16; ++t) { acc0[t] = b0; acc1[t] = b1; }
      }
#pragma unroll
      for (int rho = 0; rho < 46; ++rho) {
        const unsigned w = *(const unsigned*)(sCv + (tb + rho) * 512 + c);
        const float x0 = bflo(w), x1 = bfhi(w);
#pragma unroll
        for (int t = 0; t < 16; ++t) {
          const int k = rho - t;
          if (k >= 0 && k < 31) { acc0[t] += x0 * wk0[k]; acc1[t] += x1 * wk1[k]; }
        }
      }
      __syncthreads();
      const int tsel = ((lane >> 5) & 1) * 8 + ((lane >> 4) & 1) * 4 + ((lane >> 3) & 1) * 2 + ((lane >> 2) & 1);
      {
        float v[16];
#pragma unroll
        for (int t = 0; t < 16; ++t) v[t] = acc0[t] + acc1[t];
        const float tot = reduce16(v, lane);
        if ((lane & 3) == 0) sRed[tsel * 4 + wave] = tot;
      }
      __syncthreads();
      {
        float v[16];
#pragma unroll
        for (int t = 0; t < 16; ++t) {
          const float mean = (sRed[t * 4] + sRed[t * 4 + 1] + sRed[t * 4 + 2] + sRed[t * 4 + 3]) * (1.f / 512.f);
          acc0[t] -= mean; acc1[t] -= mean;
          v[t] = acc0[t] * acc0[t] + acc1[t] * acc1[t];
        }
        const float tot = reduce16(v, lane);
        if ((lane & 3) == 0) sRed[128 + tsel * 4 + wave] = tot;
      }
      __syncthreads();
      {
        const float g0 = lg[c], g1 = lg[c + 1], bb0 = lb[c], bb1 = lb[c + 1];
        __syncthreads();
#pragma unroll
        for (int t = 0; t < 16; ++t) {
          const float var = (sRed[128 + t * 4] + sRed[128 + t * 4 + 1] + sRed[128 + t * 4 + 2] + sRed[128 + t * 4 + 3]) * (1.f / 512.f);
          const float rstd = rsqrtf(var + 1e-6f);
          *(unsigned*)(sCv + (tb + t) * 512 + c) = pk2(siluf(acc0[t] * rstd * g0 + bb0), siluf(acc1[t] * rstd * g1 + bb1));
        }
        __syncthreads();
#pragma unroll
        for (int i = 0; i < 4; ++i) {
          const int ch = tid + 256 * i; const int r = ch >> 6, c8 = (ch & 63) * 8;
          const int row = t0 + tb + r;
          const u32x4 yv = *(const u32x4*)(sCv + (tb + r) * 512 + c8);
          const u32x4 gw = *(const u32x4*)(UA + (size_t)row * 2464 + 1440 + 512 + c8);
          u32x4 o;
          o.x = pk2(bflo(yv.x) * bflo(gw.x), bfhi(yv.x) * bfhi(gw.x));
          o.y = pk2(bflo(yv.y) * bflo(gw.y), bfhi(yv.y) * bfhi(gw.y));
          o.z = pk2(bflo(yv.z) * bflo(gw.z), bfhi(yv.z) * bfhi(gw.z));
          o.w = pk2(bflo(yv.w) * bflo(gw.w), bfhi(yv.w) * bfhi(gw.w));
          *(u32x4*)(MIX + (size_t)row * 1024 + 512 + c8) = o;
        }
      }
    }
  }
}

DI void phase_attn(const Params& p, unsigned char* smem) {
  const int tid = threadIdx.x, lane = tid & 63, wave = tid >> 6, l31 = lane & 31, hf = lane >> 5;
  constexpr int ATT_SLOT = 64 * 104 + 64 * 72;
  bf16_t* sK0 = (bf16_t*)smem;
  bf16_t* sV0 = sK0 + 64 * 104;
  const bf16_t* Q = (const bf16_t*)(p.ws + WS_Q);
  const bf16_t* KN = (const bf16_t*)(p.ws + WS_KN);
  const bf16_t* KR = (const bf16_t*)(p.ws + WS_KR);
  const bf16_t* UA = (const bf16_t*)(p.ws + WS_UA);
  bf16_t* MIX = (bf16_t*)(p.ws + WS_MIX);
  const float SC = 0.10206207261596577f * 1.4426950408889634f;
  const bool xa = (gridDim.x & 7) == 0;
  const int axcd = blockIdx.x & 7, aper = xa ? 96 : 768, anb = xa ? (gridDim.x >> 3) : gridDim.x;
  for (int idx = xa ? (blockIdx.x >> 3) : blockIdx.x; idx < aper; idx += anb) {
    const int item = xa ? ((idx < 64) ? (axcd * 64 + idx) : (512 + axcd * 32 + (idx - 64))) : idx;
    int h, Lk, tok0, kvrow0; const bf16_t* vt;
    if (item < 512) {
      const int b = item >> 6; h = (item >> 3) & 7; const int qb = item & 7; Lk = 1536;
      tok0 = T_P + b * 1024 + qb * 128; kvrow0 = T_P + b * 1536;
      vt = (const bf16_t*)(p.ws + WS_VTS) + (size_t)(b * 8 + h) * 64 * 1536;
    } else {
      const int it = item - 512; const int b = it >> 4; h = (it >> 1) & 7; const int qb = it & 1; Lk = 256;
      tok0 = b * 256 + qb * 128; kvrow0 = b * 256;
      vt = (const bf16_t*)(p.ws + WS_VTP) + (size_t)(b * 8 + h) * 64 * 256;
    }
    const int token = tok0 + wave * 32 + l31;
    bf16x8 qf[6];
#pragma unroll
    for (int ks = 0; ks < 6; ++ks) qf[ks] = *(const bf16x8*)(Q + (size_t)token * 768 + h * 96 + ks * 16 + hf * 8);
    f32x16 O[2];
#pragma unroll
    for (int r = 0; r < 16; ++r) { O[0][r] = 0.f; O[1][r] = 0.f; }
    float m_run = -INFINITY, lsum = 0.f;
    u32x4 rkA[3], rvA[2], rkB[3], rvB[2];
    const int nkt = Lk >> 6;
    auto gload = [&](int kt, u32x4 (&rk)[3], u32x4 (&rv)[2]) {
      const int k0 = kt * 64;
#pragma unroll
      for (int i = 0; i < 3; ++i) {
        const int c = tid + 256 * i; const int key = c / 12, part = c - key * 12;
        const size_t kr = (size_t)(kvrow0 + k0 + key);
        rk[i] = (part < 8) ? *(const u32x4*)(KN + kr * 512 + h * 64 + part * 8) : *(const u32x4*)(KR + kr * 32 + (part - 8) * 8);
      }
#pragma unroll
      for (int i = 0; i < 2; ++i) {
        const int c = tid + 256 * i; const int d = c >> 3, part = c & 7;
        rv[i] = *(const u32x4*)(vt + (size_t)d * Lk + k0 + part * 8);
      }
    };
    auto lstore = [&](int slot, u32x4 (&rk)[3], u32x4 (&rv)[2]) {
      bf16_t* nK = sK0 + slot * ATT_SLOT;
      bf16_t* nV = sV0 + slot * ATT_SLOT;
#pragma unroll
      for (int i = 0; i < 3; ++i) { const int c = tid + 256 * i; const int key = c / 12, part = c - key * 12; *(u32x4*)(nK + key * 104 + part * 8) = rk[i]; }
#pragma unroll
      for (int i = 0; i < 2; ++i) { const int c = tid + 256 * i; const int d = c >> 3, part = c & 7; *(u32x4*)(nV + d * 72 + part * 8) = rv[i]; }
    };
    auto compute = [&](int slot) {
      const bf16_t* sK = sK0 + slot * ATT_SLOT;
      const bf16_t* sV = sV0 + slot * ATT_SLOT;
      f32x16 S[2];
#pragma unroll
      for (int sub = 0; sub < 2; ++sub) {
#pragma unroll
        for (int r = 0; r < 16; ++r) S[sub][r] = 0.f;
#pragma unroll
        for (int ks = 0; ks < 6; ++ks) {
          const bf16x8 a = *(const bf16x8*)(sK + (sub * 32 + l31) * 104 + ks * 16 + hf * 8);
          S[sub] = MFMA32(a, qf[ks], S[sub]);
        }
      }
      float mx = -INFINITY;
#pragma unroll
      for (int r = 0; r < 16; ++r) { mx = fmaxf(mx, S[0][r]); mx = fmaxf(mx, S[1][r]); }
      mx = fmaxf(mx, __shfl_xor(mx, 32));
      const float m_new = fmaxf(m_run, mx * SC);
      const float alpha = fexp2(m_run - m_new);
      m_run = m_new;
      float ps = 0.f;
#pragma unroll
      for (int sub = 0; sub < 2; ++sub)
#pragma unroll
        for (int r = 0; r < 16; ++r) { const float e = fexp2(S[sub][r] * SC - m_new); S[sub][r] = e; ps += e; }
      lsum = lsum * alpha + ps;
#pragma unroll
      for (int r = 0; r < 16; ++r) { O[0][r] *= alpha; O[1][r] *= alpha; }
#pragma unroll
      for (int sub = 0; sub < 2; ++sub)
#pragma unroll
        for (int s2 = 0; s2 < 2; ++s2) {
          u32x4 pw;
          pw.x = pk2(S[sub][8 * s2 + 0], S[sub][8 * s2 + 1]); pw.y = pk2(S[sub][8 * s2 + 2], S[sub][8 * s2 + 3]);
          pw.z = pk2(S[sub][8 * s2 + 4], S[sub][8 * s2 + 5]); pw.w = pk2(S[sub][8 * s2 + 6], S[sub][8 * s2 + 7]);
          const bf16x8 pf = __builtin_bit_cast(bf16x8, pw);
#pragma unroll
          for (int dt = 0; dt < 2; ++dt) {
            const bf16_t* vp = sV + (dt * 32 + l31) * 72 + sub * 32 + s2 * 16 + hf * 4;
            const u32x2 lo = *(const u32x2*)vp, hi = *(const u32x2*)(vp + 8);
            u32x4 aw; aw.x = lo.x; aw.y = lo.y; aw.z = hi.x; aw.w = hi.y;
            O[dt] = MFMA32(__builtin_bit_cast(bf16x8, aw), pf, O[dt]);
          }
        }
    };
    gload(0, rkA, rvA);
    __syncthreads();
    lstore(0, rkA, rvA);
    gload(1, rkA, rvA);
    gload(2, rkB, rvB);
    for (int kt = 0; kt < nkt; kt += 2) {
      __syncthreads();
      compute(0);
      lstore(1, rkA, rvA);
      if (kt + 3 < nkt) gload(kt + 3, rkA, rvA);
      __syncthreads();
      compute(1);
      if (kt + 2 < nkt) { lstore(0, rkB, rvB); if (kt + 4 < nkt) gload(kt + 4, rkB, rvB); }
    }
    lsum += __shfl_xor(lsum, 32);
    const float inv = 1.f / lsum;
    __syncthreads();
    {
      float* sT = (float*)smem + wave * (32 * 68);
#pragma unroll
      for (int dt = 0; dt < 2; ++dt)
#pragma unroll
        for (int q4 = 0; q4 < 4; ++q4) {
          f32x4 v = {O[dt][4 * q4] * inv, O[dt][4 * q4 + 1] * inv, O[dt][4 * q4 + 2] * inv, O[dt][4 * q4 + 3] * inv};
          *(f32x4*)(sT + l31 * 68 + dt * 32 + 8 * q4 + 4 * hf) = v;
        }
      const int trow0 = tok0 + wave * 32;
      tile_rowwise8f<8>(sT, lane, [=](int row, int col, f32x4 v, f32x4 w) {
        const size_t tk = (size_t)(trow0 + row);
        const u32x4 gw = *(const u32x4*)(UA + tk * 2464 + 1440 + h * 64 + col);
        u32x4 o;
        o.x = pk2(v.x * bflo(gw.x), v.y * bfhi(gw.x));
        o.y = pk2(v.z * bflo(gw.y), v.w * bfhi(gw.y));
        o.z = pk2(w.x * bflo(gw.z), w.y * bfhi(gw.z));
        o.w = pk2(w.z * bflo(gw.w), w.w * bfhi(gw.w));
        *(u32x4*)(MIX + tk * 1024 + h * 64 + col) = o;
      });
    }
  }
}

DI void phase_conv5(const Params& p) {
  const int tid = threadIdx.x;
  const bf16_t* RAWB = (const bf16_t*)(p.ws + WS_XBCR);
  bf16_t* XC = (bf16_t*)(p.ws + WS_XBC);
  const float* cw = p.in[23];
  const float* cb = p.in[24];
  const int c = tid * 12;
  float w[5][12], bias[12];
#pragma unroll
  for (int k = 0; k < 5; ++k)
#pragma unroll
    for (int q = 0; q < 3; ++q) {
      const f32x4 a = *(const f32x4*)(cw + k * 3072 + c + 4 * q);
      w[k][4 * q] = a.x; w[k][4 * q + 1] = a.y; w[k][4 * q + 2] = a.z; w[k][4 * q + 3] = a.w;
    }
#pragma unroll
  for (int q = 0; q < 3; ++q) {
    const f32x4 a = *(const f32x4*)(cb + c + 4 * q);
    bias[4 * q] = a.x; bias[4 * q + 1] = a.y; bias[4 * q + 2] = a.z; bias[4 * q + 3] = a.w;
  }
  for (int item = blockIdx.x; item < 384; item += gridDim.x) {
    const int wt = item >> 1, side = item & 1;
    const int row0 = wt * 64;
    int s0, s1;
    if (row0 < T_P) { s0 = row0 & ~255; s1 = s0 + 256; } else { s0 = T_P + ((row0 - T_P) & ~1023); s1 = s0 + 1024; }
    unsigned raw[6][6];
#pragma unroll
    for (int r = 0; r < 6; ++r) {
      const int grow = side ? (row0 + 60 + r) : (row0 - 2 + r);
      u32x2 u0 = {0u, 0u}, u1 = {0u, 0u}, u2 = {0u, 0u};
      if (grow >= s0 && grow < s1) {
        const int tw = grow >> 6, rr = grow & 63;
        const int rb = (rr < 4) ? rr : rr - 56;
        const u32x2* sp = (const u32x2*)(RAWB + ((size_t)(tw * 8 + rb)) * 3072 + c);
        u0 = sp[0]; u1 = sp[1]; u2 = sp[2];
      }
      raw[r][0] = u0.x; raw[r][1] = u0.y; raw[r][2] = u1.x; raw[r][3] = u1.y; raw[r][4] = u2.x; raw[r][5] = u2.y;
    }
#pragma unroll
    for (int t = 0; t < 2; ++t) {
      float a[12];
#pragma unroll
      for (int e = 0; e < 12; ++e) a[e] = bias[e];
#pragma unroll
      for (int k = 0; k < 5; ++k)
#pragma unroll
        for (int d = 0; d < 6; ++d) {
          const unsigned u = raw[t + k][d];
          a[2 * d] += bflo(u) * w[k][2 * d]; a[2 * d + 1] += bfhi(u) * w[k][2 * d + 1];
        }
      u32x2 o[3];
#pragma unroll
      for (int q = 0; q < 3; ++q) { o[q].x = pk2(siluf(a[4 * q]), siluf(a[4 * q + 1])); o[q].y = pk2(siluf(a[4 * q + 2]), siluf(a[4 * q + 3])); }
      const int orow = side ? (row0 + 62 + t) : (row0 + t);
      u32x2* dp = (u32x2*)(XC + (size_t)orow * 3072 + c);
      dp[0] = o[0]; dp[1] = o[1]; dp[2] = o[2];
    }
  }
}

DI void phase_scan(const Params& p, unsigned char* smem) {
  const int tid = threadIdx.x, lane = tid & 63, wave = tid >> 6, l31 = lane & 31, hf = lane >> 5;
  bf16_t* sB = (bf16_t*)smem;
  bf16_t* sXT = sB + 128 * 136;
  bf16_t* sS = sXT + 64 * 136;
  float* sAc = (float*)(sS + 64 * 136);
  float* sDt = sAc + 128;
  float* sWg = sDt + 128;
  float* sTot = sWg + 128;
  bf16_t* sYst = (bf16_t*)(sTot + 4);
  const bf16_t* XC = (const bf16_t*)(p.ws + WS_XBC);
  const float* DT = (const float*)(p.ws + WS_DT);
  const float LOG2E = 1.4426950408889634f;
  const int lt = (blockIdx.x * 2 >= gridDim.x) ? 3 - wave : wave;
  int nb, j0, xcd;
  if ((gridDim.x & 7) == 0) { xcd = blockIdx.x & 7; j0 = blockIdx.x >> 3; nb = gridDim.x >> 3; }
  else { xcd = 0; j0 = blockIdx.x; nb = gridDim.x; }
  const int per = ((gridDim.x & 7) == 0) ? 192 : 1536;
  for (int idx = j0; idx < per; idx += nb) {
    int item;
    if ((gridDim.x & 7) == 0) item = (idx < 64) ? (xcd * 64 + idx) : (512 + xcd * 128 + (idx - 64));
    else item = idx;
    const bool smp = item < 512;
    const int it = smp ? item : item - 512;
    const int e8 = it & 7, g = (it >> 3) & 3, dir = (it >> 5) & 1, b = it >> 6, h = g * 8 + e8;
    const int L = smp ? 1024 : 256, nc = L >> 7;
    const int tokbase = smp ? (T_P + b * 1024) : (b * 256);
    const float a_neg = -fexp(p.in[26][dir * 32 + h]) * LOG2E;
    const float dsk = p.in[27][h];
    bf16_t* Y = (bf16_t*)(p.ws + (dir ? WS_YB : WS_YF));
    f32x16 accS[2];
    if (smp) {
      const float* st = p.in[4] + ((size_t)(b * 2 + dir) * 32 + h) * 8192;
#pragma unroll
      for (int pt = 0; pt < 2; ++pt)
#pragma unroll
        for (int q4 = 0; q4 < 4; ++q4) {
          const f32x4 v4 = *(const f32x4*)(st + (pt * 32 + l31) * 128 + wave * 32 + 8 * q4 + 4 * hf);
          accS[pt][4 * q4] = v4.x; accS[pt][4 * q4 + 1] = v4.y; accS[pt][4 * q4 + 2] = v4.z; accS[pt][4 * q4 + 3] = v4.w;
        }
    } else {
#pragma unroll
      for (int pt = 0; pt < 2; ++pt)
#pragma unroll
        for (int r = 0; r < 16; ++r) accS[pt][r] = 0.f;
    }
    u32x4 rB[8], rX[4]; float rdt = 0.f; bf16x8 cf[8];
    auto prefetch = [&](int c) {
#pragma unroll
      for (int i = 0; i < 8; ++i) {
        const int ch = tid + 256 * i; const int r = ch >> 4, part = ch & 15;
        const int pos = c * 128 + r; const int tok = tokbase + (dir ? (L - 1 - pos) : pos);
        rB[i] = *(const u32x4*)(XC + (size_t)tok * 3072 + 2048 + g * 128 + part * 8);
      }
#if PF_X
#pragma unroll
      for (int i = 0; i < 4; ++i) {
        const int ch = tid + 256 * i; const int r = ch & 127, part = ch >> 7;
        const int pos = c * 128 + r; const int tok = tokbase + (dir ? (L - 1 - pos) : pos);
        rX[i] = *(const u32x4*)(XC + (size_t)tok * 3072 + h * 64 + part * 8);
      }
#endif
      if (tid < 128) {
        const int pos = c * 128 + tid; const int tok = tokbase + (dir ? (L - 1 - pos) : pos);
        rdt = DT[(size_t)tok * 64 + dir * 32 + h];
      }
    };
    auto load_cf = [&](int c) {
      const int pos = c * 128 + lt * 32 + l31; const int tok = tokbase + (dir ? (L - 1 - pos) : pos);
      const bf16_t* cp = XC + (size_t)tok * 3072 + 2560 + g * 128 + hf * 8;
#pragma unroll
      for (int ks = 0; ks < 8; ++ks) cf[ks] = *(const bf16x8*)(cp + ks * 16);
    };
    prefetch(0);
#if PF_C
    load_cf(0);
#endif
    __syncthreads();
#pragma unroll
    for (int pt = 0; pt < 2; ++pt)
#pragma unroll
      for (int q4 = 0; q4 < 4; ++q4) {
        u32x2 o; o.x = pk2(accS[pt][4 * q4], accS[pt][4 * q4 + 1]); o.y = pk2(accS[pt][4 * q4 + 2], accS[pt][4 * q4 + 3]);
        *(u32x2*)(sS + (pt * 32 + l31) * 136 + wave * 32 + 8 * q4 + 4 * hf) = o;
      }

    for (int c = 0; c < nc; ++c) {
#if !PF_C
      load_cf(c);
#endif
#pragma unroll
      for (int i = 0; i < 8; ++i) { const int ch = tid + 256 * i; const int r = ch >> 4, part = ch & 15; *(u32x4*)(sB + r * 136 + part * 8) = rB[i]; }
#if !PF_X
#pragma unroll
      for (int i = 0; i < 4; ++i) {
        const int ch = tid + 256 * i; const int r = ch & 127, part = ch >> 7;
        const int pos = c * 128 + r; const int tok = tokbase + (dir ? (L - 1 - pos) : pos);
        rX[i] = *(const u32x4*)(XC + (size_t)tok * 3072 + h * 64 + part * 8);
      }
#endif
#pragma unroll
      for (int i = 0; i < 4; ++i) {
        const int ch = tid + 256 * i; const int r = ch & 127, part = ch >> 7;
        const u32x4 v = rX[i];
        bf16_t* d = sXT + (part * 8) * 136 + r;
        d[0] = (bf16_t)(v.x & 0xffff); d[136] = (bf16_t)(v.x >> 16);
        d[2 * 136] = (bf16_t)(v.y & 0xffff); d[3 * 136] = (bf16_t)(v.y >> 16);
        d[4 * 136] = (bf16_t)(v.z & 0xffff); d[5 * 136] = (bf16_t)(v.z >> 16);
        d[6 * 136] = (bf16_t)(v.w & 0xffff); d[7 * 136] = (bf16_t)(v.w >> 16);
      }
      const float dtv = rdt;
      float v = (tid < 128) ? dtv * a_neg : 0.f;
#pragma unroll
      for (int o = 1; o < 64; o <<= 1) { const float t = __shfl_up(v, o); if (lane >= o) v += t; }
      if (lane == 63) sTot[wave] = v;
      __syncthreads();
      if (wave == 1) v += sTot[0];
      if (tid < 128) { sAc[tid] = v; sDt[tid] = dtv; }
      __syncthreads();
      const float a_last = sAc[127];
      if (tid < 128) sWg[tid] = dtv * fexp2(a_last - v);
      const float acl = sAc[lt * 32 + l31];
      const float ea_l = fexp2(acl);
      f32x16 accY[2];
#pragma unroll
      for (int pt = 0; pt < 2; ++pt) {
#pragma unroll
        for (int r = 0; r < 16; ++r) accY[pt][r] = 0.f;
#pragma unroll
        for (int ks = 0; ks < 8; ++ks) {
          const bf16x8 a = *(const bf16x8*)(sS + (pt * 32 + l31) * 136 + ks * 16 + hf * 8);
          accY[pt] = MFMA32(a, cf[ks], accY[pt]);
        }
#pragma unroll
        for (int r = 0; r < 16; ++r) accY[pt][r] *= ea_l;
      }
      float* sw2 = (float*)(sYst + wave * (32 * 40));
      float el = 0.f;
      if (lt > 0) {
        const float a_ref = sAc[lt * 32 - 1];
        el = fexp2(acl - a_ref);
        for (int sidx = lane; sidx < lt * 32; sidx += 64) sw2[sidx] = fexp2(a_ref - sAc[sidx]) * sDt[sidx];
      }
      auto diag_tile = [&](int st, auto diag_tag) {
        constexpr bool DIAG = decltype(diag_tag)::value;
        f32x16 cbT;
#pragma unroll
        for (int r = 0; r < 16; ++r) cbT[r] = 0.f;
#pragma unroll
        for (int ks = 0; ks < 8; ++ks) {
          const bf16x8 a = *(const bf16x8*)(sB + (st * 32 + l31) * 136 + ks * 16 + hf * 8);
          cbT = MFMA32(a, cf[ks], cbT);
        }
        const int lrow = lt * 32 + l31;
        if (!DIAG) {
#pragma unroll
          for (int q4 = 0; q4 < 4; ++q4) {
            const f32x4 w4 = *(const f32x4*)(sw2 + st * 32 + 8 * q4 + 4 * hf);
            cbT[4 * q4 + 0] *= el * w4.x; cbT[4 * q4 + 1] *= el * w4.y; cbT[4 * q4 + 2] *= el * w4.z; cbT[4 * q4 + 3] *= el * w4.w;
          }
        } else {
#pragma unroll 1
          for (int q4h = 0; q4h < 2; ++q4h)
#pragma unroll
          for (int q4 = 2 * q4h; q4 < 2 * q4h + 2; ++q4) {
            const int sbase = st * 32 + 8 * q4 + 4 * hf;
            const f32x4 ac4 = *(const f32x4*)(sAc + sbase);
            const f32x4 dt4 = *(const f32x4*)(sDt + sbase);
            cbT[4 * q4 + 0] = (sbase + 0 <= lrow) ? cbT[4 * q4 + 0] * fexp2(acl - ac4.x) * dt4.x : 0.f;
            cbT[4 * q4 + 1] = (sbase + 1 <= lrow) ? cbT[4 * q4 + 1] * fexp2(acl - ac4.y) * dt4.y : 0.f;
            cbT[4 * q4 + 2] = (sbase + 2 <= lrow) ? cbT[4 * q4 + 2] * fexp2(acl - ac4.z) * dt4.z : 0.f;
            cbT[4 * q4 + 3] = (sbase + 3 <= lrow) ? cbT[4 * q4 + 3] * fexp2(acl - ac4.w) * dt4.w : 0.f;
          }
        }
#pragma unroll
        for (int s2 = 0; s2 < 2; ++s2) {
          u32x4 pw;
          pw.x = pk2(cbT[8 * s2 + 0], cbT[8 * s2 + 1]); pw.y = pk2(cbT[8 * s2 + 2], cbT[8 * s2 + 3]);
          pw.z = pk2(cbT[8 * s2 + 4], cbT[8 * s2 + 5]); pw.w = pk2(cbT[8 * s2 + 6], cbT[8 * s2 + 7]);
          const bf16x8 pf = __builtin_bit_cast(bf16x8, pw);
#pragma unroll
          for (int pt = 0; pt < 2; ++pt) {
            const bf16_t* xp = sXT + (pt * 32 + l31) * 136 + st * 32 + s2 * 16 + hf * 4;
            const u32x2 lo = *(const u32x2*)xp, hi = *(const u32x2*)(xp + 8);
            u32x4 aw; aw.x = lo.x; aw.y = lo.y; aw.z = hi.x; aw.w = hi.y;
            accY[pt] = MFMA32(__builtin_bit_cast(bf16x8, aw), pf, accY[pt]);
          }
        }
      };
      for (int st = 0; st < lt; ++st) diag_tile(st, std::false_type{});
      diag_tile(lt, std::true_type{});
      {
        bf16_t* yst = sYst + wave * (32 * 40);
#pragma unroll
        for (int pt = 0; pt < 2; ++pt) {
#pragma unroll
          for (int q4 = 0; q4 < 4; ++q4) {
            u32x2 o; o.x = pk2(accY[pt][4 * q4], accY[pt][4 * q4 + 1]); o.y = pk2(accY[pt][4 * q4 + 2], accY[pt][4 * q4 + 3]);
            *(u32x2*)(yst + l31 * 40 + 8 * q4 + 4 * hf) = o;
          }
#pragma unroll
          for (int it = 0; it < 2; ++it) {
            const int row = (lane >> 2) + 16 * it, chunk = lane & 3;
            const u32x4 v4 = *(const u32x4*)(yst + row * 40 + chunk * 8);
            const int pos = c * 128 + lt * 32 + row; const int tok = tokbase + (dir ? (L - 1 - pos) : pos);
            u32x4 o4 = v4;
            if (dir == 0) {
              const u32x4 xv = *(const u32x4*)(XC + (size_t)tok * 3072 + h * 64 + pt * 32 + chunk * 8);
              o4.x = pk2(bflo(v4.x) + dsk * bflo(xv.x), bfhi(v4.x) + dsk * bfhi(xv.x));
              o4.y = pk2(bflo(v4.y) + dsk * bflo(xv.y), bfhi(v4.y) + dsk * bfhi(xv.y));
              o4.z = pk2(bflo(v4.z) + dsk * bflo(xv.z), bfhi(v4.z) + dsk * bfhi(xv.z));
              o4.w = pk2(bflo(v4.w) + dsk * bflo(xv.w), bfhi(v4.w) + dsk * bfhi(xv.w));
            }
            *(u32x4*)(Y + (size_t)tok * 2048 + h * 64 + pt * 32 + chunk * 8) = o4;
          }
        }
      }
      __syncthreads();
      if (c + 1 < nc) {
        prefetch(c + 1);
#if PF_C
        load_cf(c + 1);
#endif
      }
      {
        const float dec = fexp2(a_last);
#pragma unroll
        for (int pt = 0; pt < 2; ++pt)
#pragma unroll
          for (int r = 0; r < 16; ++r) accS[pt][r] *= dec;
#pragma unroll 2
        for (int ks = 0; ks < 8; ++ks) {
          const int sb = ks * 16 + hf * 8;
          const f32x4 w0 = *(const f32x4*)(sWg + sb), w1 = *(const f32x4*)(sWg + sb + 4);
          const bf16_t* bp = sB + sb * 136 + wave * 32 + l31;
          u32x4 bw;
          bw.x = pk2(bf2f(bp[0]) * w0.x, bf2f(bp[136]) * w0.y);
          bw.y = pk2(bf2f(bp[2 * 136]) * w0.z, bf2f(bp[3 * 136]) * w0.w);
          bw.z = pk2(bf2f(bp[4 * 136]) * w1.x, bf2f(bp[5 * 136]) * w1.y);
          bw.w = pk2(bf2f(bp[6 * 136]) * w1.z, bf2f(bp[7 * 136]) * w1.w);
          const bf16x8 bfrag = __builtin_bit_cast(bf16x8, bw);
#pragma unroll
          for (int pt = 0; pt < 2; ++pt) {
            const bf16x8 a = *(const bf16x8*)(sXT + (pt * 32 + l31) * 136 + ks * 16 + hf * 8);
            accS[pt] = MFMA32(bfrag, a, accS[pt]);
          }
        }
      }
#pragma unroll
      for (int pt = 0; pt < 2; ++pt)
#pragma unroll
        for (int q4 = 0; q4 < 4; ++q4) {
          u32x2 o; o.x = pk2(accS[pt][4 * q4], accS[pt][4 * q4 + 1]); o.y = pk2(accS[pt][4 * q4 + 2], accS[pt][4 * q4 + 3]);
          *(u32x2*)(sS + (pt * 32 + l31) * 136 + wave * 32 + 8 * q4 + 4 * hf) = o;
        }
      __syncthreads();
    }
    if (!smp) {
      float* o = p.out + OUT_ST + ((size_t)(b * 2 + dir) * 32 + h) * 8192;
#pragma unroll
      for (int pt = 0; pt < 2; ++pt)
#pragma unroll
        for (int q4 = 0; q4 < 4; ++q4) {
          f32x4 v4 = {accS[pt][4 * q4], accS[pt][4 * q4 + 1], accS[pt][4 * q4 + 2], accS[pt][4 * q4 + 3]};
          *(f32x4*)(o + (pt * 32 + l31) * 128 + wave * 32 + 8 * q4 + 4 * hf) = v4;
        }
    }
  }
}

DI void phase_combine(const Params& p) {
  const int tid = threadIdx.x, lane = tid & 63, wave = tid >> 6;
  const bf16_t* YF = (const bf16_t*)(p.ws + WS_YF);
  const bf16_t* YB = (const bf16_t*)(p.ws + WS_YB);
  const bf16_t* XC = (const bf16_t*)(p.ws + WS_XBC);
  bf16_t* Z = (bf16_t*)(p.ws + WS_Z);
  const float* dsk = p.in[27];
  const float* gn = p.in[28];
  for (int row = blockIdx.x * 4 + wave; row < T_ALL; row += gridDim.x * 4) {
    float v[32]; float ss = 0.f;
#pragma unroll
    for (int j = 0; j < 4; ++j) {
      const int c = lane * 8 + 512 * j;
      const u32x4 yf = *(const u32x4*)(YF + (size_t)row * 2048 + c);
      const u32x4 yb = *(const u32x4*)(YB + (size_t)row * 2048 + c);
      const u32x4 z = *(const u32x4*)(Z + (size_t)row * 2048 + c);
      const unsigned yfw[4] = {yf.x, yf.y, yf.z, yf.w}, ybw[4] = {yb.x, yb.y, yb.z, yb.w}, zw[4] = {z.x, z.y, z.z, z.w};
#pragma unroll
      for (int e = 0; e < 4; ++e) {
        const float a = (bflo(yfw[e]) + bflo(ybw[e])) * siluf(bflo(zw[e]));
        const float b = (bfhi(yfw[e]) + bfhi(ybw[e])) * siluf(bfhi(zw[e]));
        v[j * 8 + 2 * e] = a; v[j * 8 + 2 * e + 1] = b; ss += a * a + b * b;
      }
    }
    ss = wave_sum(ss);
    const float rstd = rsqrtf(ss * (1.f / 2048.f) + 1e-6f);
#pragma unroll
    for (int j = 0; j < 4; ++j) {
      const int c = lane * 8 + 512 * j;
      const f32x4 g0 = *(const f32x4*)(gn + c), g1 = *(const f32x4*)(gn + c + 4);
      u32x4 o;
      o.x = pk2(v[j * 8 + 0] * rstd * g0.x, v[j * 8 + 1] * rstd * g0.y);
      o.y = pk2(v[j * 8 + 2] * rstd * g0.z, v[j * 8 + 3] * rstd * g0.w);
      o.z = pk2(v[j * 8 + 4] * rstd * g1.x, v[j * 8 + 5] * rstd * g1.y);
      o.w = pk2(v[j * 8 + 6] * rstd * g1.z, v[j * 8 + 7] * rstd * g1.w);
      *(u32x4*)(Z + (size_t)row * 2048 + c) = o;
    }
  }
}

DI void phase_final(const Params& p) {
  const int tid = threadIdx.x, lane = tid & 63, wave = tid >> 6;
  const float* g = p.in[10];
  const bf16_t* X2 = (const bf16_t*)(p.ws + WS_X2);
  const int nw = gridDim.x * 4;
  for (int row = blockIdx.x * 4 + wave; row < T_ALL; row += 2 * nw) {
    const int row2 = row + nw;
    const bool has2 = row2 < T_ALL;
    const int rb = has2 ? row2 : row;
    u32x4 a[2], b[2];
#pragma unroll
    for (int jj = 0; jj < 2; ++jj) { a[jj] = *(const u32x4*)(X2 + (size_t)row * 1024 + lane * 8 + 512 * jj); b[jj] = *(const u32x4*)(X2 + (size_t)rb * 1024 + lane * 8 + 512 * jj); }
    float va[16], vb[16]; float ss = 0.f, ss2 = 0.f;
#pragma unroll
    for (int jj = 0; jj < 2; ++jj) {
      const unsigned aw[4] = {a[jj].x, a[jj].y, a[jj].z, a[jj].w}, bw[4] = {b[jj].x, b[jj].y, b[jj].z, b[jj].w};
#pragma unroll
      for (int e = 0; e < 4; ++e) {
        va[jj * 8 + 2 * e] = bflo(aw[e]); va[jj * 8 + 2 * e + 1] = bfhi(aw[e]);
        vb[jj * 8 + 2 * e] = bflo(bw[e]); vb[jj * 8 + 2 * e + 1] = bfhi(bw[e]);
      }
    }
#pragma unroll
    for (int i = 0; i < 16; ++i) { ss += va[i] * va[i]; ss2 += vb[i] * vb[i]; }
    ss = wave_sum(ss); ss2 = wave_sum(ss2);
    const float rstd = rsqrtf(ss * (1.f / 1024.f) + 1e-6f), rstd2 = rsqrtf(ss2 * (1.f / 1024.f) + 1e-6f);
    float* yr = p.out + OUT_Y + (size_t)row * 1024;
    float* yr2 = p.out + OUT_Y + (size_t)rb * 1024;
#pragma unroll
    for (int jj = 0; jj < 2; ++jj)
#pragma unroll
      for (int hq = 0; hq < 2; ++hq) {
        const int c = lane * 8 + 512 * jj + 4 * hq;
        const f32x4 gg = *(const f32x4*)(g + c);
        const int i0 = jj * 8 + hq * 4;
        f32x4 o = {va[i0] * rstd * gg.x, va[i0 + 1] * rstd * gg.y, va[i0 + 2] * rstd * gg.z, va[i0 + 3] * rstd * gg.w};
        *(f32x4*)(yr + c) = o;
        if (has2) {
          f32x4 o2 = {vb[i0] * rstd2 * gg.x, vb[i0 + 1] * rstd2 * gg.y, vb[i0 + 2] * rstd2 * gg.z, vb[i0 + 3] * rstd2 * gg.w};
          *(f32x4*)(yr2 + c) = o2;
        }
      }
  }
}

constexpr int N_PHASES = 14;
#ifndef PHASE_ONLY
#define PHASE_ONLY -1
#endif
#define PH_EN(k) (PHASE_ONLY < 0 || PHASE_ONLY == (k))

#ifndef DUP_MASK
#define DUP_MASK 0
#endif
#define RUN_PHASE(k, ...) if (PH_EN(k) && ph_lo <= (k) && (k) < ph_hi) { if ((k) > ph_lo) xcd_barrier(xb); __VA_ARGS__ \
    if ((DUP_MASK >> (k)) & 1) { xcd_barrier(xb); __VA_ARGS__ } }

__global__ void __launch_bounds__(NTHR, 2) mega(Params p, int ph_lo, int ph_hi) {
  extern __shared__ __attribute__((aligned(16))) unsigned char smem[];
  volatile LAS unsigned* xst = (volatile LAS unsigned*)(smem + LDS_BYTES - 16);
  if (threadIdx.x == 0) { xst[0] = 0u; xst[1] = 0u; xst[2] = 0u; xst[3] = 0u; }
  __syncthreads();
  XcdBarrier xb = xcd_barrier_post((unsigned*)(p.ws + WS_BAR), xst);
  if (ph_hi > 1000) cg::this_grid().sync();
  RUN_PHASE(0, phase0(p, smem);)
  RUN_PHASE(1, phase_h(p, 0, p.in[0], p.in[1], nullptr, (bf16_t*)(p.ws + WS_H0), smem);)
  RUN_PHASE(2, {
    EpiAin e{(bf16_t*)(p.ws + WS_UA)};
    gemm_phase<true>((const bf16_t*)(p.ws + WS_H0), 1024, (const bf16_t*)(p.ws + WS_WT_AIN), 1024, 1024, 96, 20, smem, e);
  })
  RUN_PHASE(3, phase3(p, smem);)
  RUN_PHASE(4, {
    EpiQ eq{(bf16_t*)(p.ws + WS_Q), (const float*)(p.ws + WS_ROPE)};
    gemm_phase<true>((const bf16_t*)(p.ws + WS_QN), 256, (const bf16_t*)(p.ws + WS_WT_UQ), 256, 256, 96, 6, smem, eq);
    EpiKV ek{(bf16_t*)(p.ws + WS_KN), (bf16_t*)(p.ws + WS_VTP), (bf16_t*)(p.ws + WS_VTS)};
    gemm_phase<true>((const bf16_t*)(p.ws + WS_CKV), 128, (const bf16_t*)(p.ws + WS_WT_UKV), 128, 128, 128, 8, smem, ek);
  })
  RUN_PHASE(5, phase_attn(p, smem);)
  RUN_PHASE(6, {
    EpiRes e{(const float*)(p.ws + WS_MODP), 0, p.in[0], p.in[1], nullptr, (bf16_t*)(p.out + OUT_Y), nullptr, 0};
    gemm_phase<true>((const bf16_t*)(p.ws + WS_MIX), 1024, (const bf16_t*)(p.ws + WS_WT_AOUT), 1024, 1024, 96, 8, smem, e);
    if ((gridDim.x & 7) == 0 && gridDim.x == 512) { const int j = blockIdx.x >> 3; if (j >= 32) convert_c_weights(p, (j - 32) * 8 + (blockIdx.x & 7), 256, smem); }
    else convert_c_weights(p, blockIdx.x, gridDim.x, smem);
  })
  RUN_PHASE(7, phase_h(p, 1, nullptr, nullptr, (const bf16_t*)(p.out + OUT_Y), (bf16_t*)(p.ws + WS_H1), smem);)
  RUN_PHASE(8, {
    EpiCin e{(bf16_t*)(p.ws + WS_Z), (bf16_t*)(p.ws + WS_XBCR)  , (bf16_t*)(p.ws + WS_XBC), (float*)(p.ws + WS_DT), p.in[25], p.in[23], p.in[24]};
    gemm_phase<true>((const bf16_t*)(p.ws + WS_H1), 1024, (const bf16_t*)(p.ws + WS_WT_CIN), 1024, 1024, 96, 41, smem, e);
  })
  RUN_PHASE(9, phase_conv5(p);)
  RUN_PHASE(10, phase_scan(p, smem);)
  RUN_PHASE(11, phase_combine(p);)
  RUN_PHASE(12, {
    EpiRes e{(const float*)(p.ws + WS_MODP), 1, nullptr, nullptr, (const bf16_t*)(p.out + OUT_Y), (bf16_t*)(p.ws + WS_X2), nullptr, 0};
    gemm_phase<true, 2>((const bf16_t*)(p.ws + WS_Z), 2048, (const bf16_t*)(p.ws + WS_WT_COUT), 2048, 1024, 96, 8, smem, e);
  })
  RUN_PHASE(13, phase_final(p);)
}

extern "C" void kernel_launch(void* const* d_in, const int* in_sizes, int n_in, void* d_out, int out_size,
                              void* d_ws, size_t ws_size, hipStream_t stream) {
  static int grid_blocks = 0;
  if (grid_blocks == 0) {
    if (n_in != 30 || ws_size < WS_NEED) {
      fprintf(stderr, "kernel_launch: expected 30 inputs and >= %zu B of workspace, got %d / %zu\n", (size_t)WS_NEED, n_in, ws_size);
      grid_blocks = -1; return;
    }
    int dev = 0, cus = 0, per_cu = 0;
    hipGetDevice(&dev);
    hipDeviceGetAttribute(&cus, hipDeviceAttributeMultiprocessorCount, dev);
    if (hipFuncSetAttribute((const void*)mega, hipFuncAttributeMaxDynamicSharedMemorySize, LDS_BYTES) != hipSuccess)
      fprintf(stderr, "kernel_launch: hipFuncSetAttribute failed\n");
    if (hipOccupancyMaxActiveBlocksPerMultiprocessor(&per_cu, (const void*)mega, NTHR, LDS_BYTES) != hipSuccess || per_cu < 1) {
      fprintf(stderr, "kernel_launch: occupancy query failed (%d)\n", per_cu);
      per_cu = 1;
    }
    if (per_cu > 2) per_cu = 2;
    grid_blocks = cus * per_cu;
    (void)hipGetLastError();
  }
  if (grid_blocks < 0) return;
  Params p{};
  for (int i = 0; i < 30; ++i) p.in[i] = (const float*)d_in[i];
  p.out = (float*)d_out;
  p.ws = (unsigned char*)d_ws;
#if ONE_LAUNCH
  if (hipMemsetAsync((unsigned char*)d_ws + WS_BAR, 0, XCD_BAR_WORDS * 4, stream) != hipSuccess) fprintf(stderr, "kernel_launch: memset of barrier words failed\n");
  int lo = 0, hi = N_PHASES;
  void* args[] = {&p, &lo, &hi};
  hipError_t e = hipLaunchCooperativeKernel((const void*)mega, dim3(grid_blocks), dim3(NTHR), args, LDS_BYTES, stream);
  if (e != hipSuccess) fprintf(stderr, "cooperative launch failed: %s (grid %d)\n", hipGetErrorString(e), grid_blocks);
#else
  for (int ph = 0; ph < N_PHASES; ++ph) {
    hipLaunchKernelGGL(mega, dim3(grid_blocks), dim3(NTHR), LDS_BYTES, stream, p, ph, ph + 1);
  }
#endif
}
```
